# Optimizing an MI355X kernel written in HIP

```python
import math
import jax, jax.numpy as jnp
from jax import lax
import numpy as np

D_MODEL = 1024
BATCH = 4
SEQ = 4096
DEPTH = 1

N_Q_HEADS = 8
N_KV_HEADS = 2
HEAD_DIM = 64
Q_GROUP = N_Q_HEADS // N_KV_HEADS
ATTN_WIDTH = N_Q_HEADS * HEAD_DIM
KV_WIDTH = N_KV_HEADS * HEAD_DIM
WINDOW = 128
BLOCK = 128
N_BUCKETS = 32
MAX_DISTANCE = 128
NEG_INF = -1e30
SSM_WIDTH = D_MODEL // 2
SSM_GROUP = 16
SSM_GROUPS = SSM_WIDTH // SSM_GROUP
SSM_STATE = 64
DT_MIN = 1e-3
DT_MAX = 1e-1
N_BRANCHES = 2
D_FF = 4 * D_MODEL
IN_WIDTH = ATTN_WIDTH + 2 * KV_WIDTH + SSM_WIDTH + N_BRANCHES * D_MODEL
SPLITS = (ATTN_WIDTH, ATTN_WIDTH + KV_WIDTH, ATTN_WIDTH + 2 * KV_WIDTH,
          ATTN_WIDTH + 2 * KV_WIDTH + SSM_WIDTH, ATTN_WIDTH + 2 * KV_WIDTH + SSM_WIDTH + D_MODEL)
RMS_EPS = 1e-6

kernel_name = "hybrid_swa_sink_s5_gated_block"


def rmsnorm(x, g):
    xf = x.astype(jnp.float32)
    y = xf * lax.rsqrt(jnp.mean(xf * xf, axis=-1, keepdims=True) + RMS_EPS)
    return (y * g.astype(jnp.float32)).astype(x.dtype)


def t5_causal_bucket(dist):
    max_exact = N_BUCKETS // 2
    d = jnp.maximum(dist, 0)
    df = jnp.maximum(d, 1).astype(jnp.float32)
    large = max_exact + (jnp.log(df / max_exact) / math.log(MAX_DISTANCE / max_exact)
                         * (N_BUCKETS - max_exact)).astype(jnp.int32)
    large = jnp.minimum(large, N_BUCKETS - 1)
    return jnp.where(d < max_exact, d, large)


def sliding_window_attention(q, k, v, sinks, rel_bias):
    B, L = q.shape[0], q.shape[1]
    nb = L // BLOCK
    qb = q.reshape(B, nb, BLOCK, N_KV_HEADS, Q_GROUP, HEAD_DIM)

    def band(t):
        tb = t.reshape(B, nb, BLOCK, N_KV_HEADS, HEAD_DIM)
        prev = jnp.pad(tb, ((0, 0), (1, 0), (0, 0), (0, 0), (0, 0)))[:, :-1]
        return jnp.concatenate([prev, tb], axis=2)

    kb, vb = band(k), band(v)
    logits = jnp.einsum('bnqkgd,bnskd->bnkgqs', qb, kb,
                        preferred_element_type=jnp.float32) * (HEAD_DIM ** -0.5)
    qi = jnp.arange(BLOCK)[:, None]
    kj = jnp.arange(2 * BLOCK)[None, :]
    dist = qi + BLOCK - kj
    band_ok = (dist >= 0) & (dist < WINDOW)
    key_pos = jnp.arange(nb)[:, None] * BLOCK - BLOCK + jnp.arange(2 * BLOCK)[None, :]
    mask = band_ok[None] & (key_pos >= 0)[:, None, :]
    bias = rel_bias.astype(jnp.float32)[t5_causal_bucket(dist)]
    bias = jnp.transpose(bias, (2, 0, 1)).reshape(N_KV_HEADS, Q_GROUP, BLOCK, 2 * BLOCK)
    logits = jnp.where(mask[None, :, None, None], logits + bias[None, None], NEG_INF)
    s = sinks.astype(jnp.float32).reshape(1, 1, N_KV_HEADS, Q_GROUP, 1, 1)
    m = jnp.maximum(jnp.max(logits, axis=-1, keepdims=True), s)
    p = jnp.exp(logits - m)
    denom = jnp.sum(p, axis=-1, keepdims=True) + jnp.exp(s - m)
    probs = (p / denom).astype(v.dtype)
    out = jnp.einsum('bnkgqs,bnskd->bnqkgd', probs, vb)
    return out.reshape(B, L, ATTN_WIDTH)


def s5_ssm(u, lam_re, lam_im, log_dt, b_re, b_im, c_re, c_im, d_skip):
    B, L = u.shape[0], u.shape[1]
    uf = u.astype(jnp.float32).reshape(B, L, SSM_GROUPS, SSM_GROUP)
    dt = jnp.exp(log_dt.astype(jnp.float32))[:, None]
    lr = lam_re.astype(jnp.float32)
    li = lam_im.astype(jnp.float32)
    mag = jnp.exp(lr * dt)
    ab_re = mag * jnp.cos(li * dt)
    ab_im = mag * jnp.sin(li * dt)
    nr = ab_re - 1.0
    den = lr * lr + li * li
    f_re = (nr * lr + ab_im * li) / den
    f_im = (ab_im * lr - nr * li) / den
    br = b_re.astype(jnp.float32)
    bi = b_im.astype(jnp.float32)
    bb_re = f_re[..., None] * br - f_im[..., None] * bi
    bb_im = f_re[..., None] * bi + f_im[..., None] * br
    bu_re = jnp.einsum('blgc,gpc->blgp', uf, bb_re)
    bu_im = jnp.einsum('blgc,gpc->blgp', uf, bb_im)
    a_re = jnp.broadcast_to(ab_re, bu_re.shape)
    a_im = jnp.broadcast_to(ab_im, bu_im.shape)

    def combine(e1, e2):
        a1r, a1i, b1r, b1i = e1
        a2r, a2i, b2r, b2i = e2
        return (a2r * a1r - a2i * a1i,
                a2r * a1i + a2i * a1r,
                a2r * b1r - a2i * b1i + b2r,
                a2r * b1i + a2i * b1r + b2i)

    _, _, h_re, h_im = lax.associative_scan(combine, (a_re, a_im, bu_re, bu_im), axis=1)
    y = (jnp.einsum('blgp,gcp->blgc', h_re, c_re.astype(jnp.float32))
         - jnp.einsum('blgp,gcp->blgc', h_im, c_im.astype(jnp.float32)))
    y = y + d_skip.astype(jnp.float32).reshape(SSM_GROUPS, SSM_GROUP) * uf
    return y.reshape(B, L, SSM_WIDTH).astype(u.dtype)


def setup_inputs(seed: int = 0) -> dict:
    key = jax.random.key(seed)
    ks = jax.random.split(key, 24)
    f32 = jnp.float32
    nrm = lambda k, shape, scale: jax.random.normal(k, shape, f32) * scale
    n_idx = jnp.arange(SSM_STATE, dtype=f32)
    return {
        "x": jax.random.normal(ks[0], (BATCH, SEQ, D_MODEL), f32),
        "norm_mix_pre": 1.0 + nrm(ks[1], (DEPTH, D_MODEL), 0.05),
        "norm_mix_post": 1.0 + nrm(ks[2], (DEPTH, D_MODEL), 0.05),
        "norm_mlp_pre": 1.0 + nrm(ks[3], (DEPTH, D_MODEL), 0.05),
        "norm_mlp_post": 1.0 + nrm(ks[4], (DEPTH, D_MODEL), 0.05),
        "w_in": nrm(ks[5], (DEPTH, D_MODEL, IN_WIDTH), D_MODEL ** -0.5),
        "rel_bias": nrm(ks[6], (N_BUCKETS, N_Q_HEADS), 0.5),
        "sinks": nrm(ks[7], (DEPTH, N_Q_HEADS), 0.5),
        "lam_re": -0.5 + nrm(ks[8], (DEPTH, SSM_GROUPS, SSM_STATE), 0.02),
        "lam_im": math.pi * n_idx + nrm(ks[9], (DEPTH, SSM_GROUPS, SSM_STATE), 0.02),
        "log_dt": jax.random.uniform(ks[10], (DEPTH, SSM_GROUPS), f32,
                                     math.log(DT_MIN), math.log(DT_MAX)),
        "b_re": nrm(ks[11], (DEPTH, SSM_GROUPS, SSM_STATE, SSM_GROUP), SSM_GROUP ** -0.5),
        "b_im": nrm(ks[12], (DEPTH, SSM_GROUPS, SSM_STATE, SSM_GROUP), SSM_GROUP ** -0.5),
        "c_re": nrm(ks[13], (DEPTH, SSM_GROUPS, SSM_GROUP, SSM_STATE), SSM_STATE ** -0.5),
        "c_im": nrm(ks[14], (DEPTH, SSM_GROUPS, SSM_GROUP, SSM_STATE), SSM_STATE ** -0.5),
        "d_skip": nrm(ks[15], (DEPTH, SSM_WIDTH), 1.0),
        "w_glu": nrm(ks[16], (DEPTH, SSM_WIDTH, SSM_WIDTH), SSM_WIDTH ** -0.5),
        "w_attn_branch": nrm(ks[17], (DEPTH, ATTN_WIDTH, D_MODEL), ATTN_WIDTH ** -0.5),
        "w_ssm_branch": nrm(ks[18], (DEPTH, SSM_WIDTH, D_MODEL), SSM_WIDTH ** -0.5),
        "w_out": nrm(ks[19], (DEPTH, D_MODEL, D_MODEL), D_MODEL ** -0.5),
        "w_ff_in": nrm(ks[20], (DEPTH, D_MODEL, D_FF), D_MODEL ** -0.5),
        "w_ff_out": nrm(ks[21], (DEPTH, D_FF, D_MODEL), D_FF ** -0.5),
    }


def reference(x, norm_mix_pre, norm_mix_post, norm_mlp_pre, norm_mlp_post, w_in, rel_bias,
              sinks, lam_re, lam_im, log_dt, b_re, b_im, c_re, c_im, d_skip, w_glu,
              w_attn_branch, w_ssm_branch, w_out, w_ff_in, w_ff_out):
    B, L = x.shape[0], x.shape[1]
    for l in range(DEPTH):
        h = rmsnorm(x, norm_mix_pre[l])
        proj = h @ w_in[l]
        q, k, v, u, g_attn, g_ssm = jnp.split(proj, SPLITS, axis=-1)
        q = q.reshape(B, L, N_Q_HEADS, HEAD_DIM)
        k = k.reshape(B, L, N_KV_HEADS, HEAD_DIM)
        v = v.reshape(B, L, N_KV_HEADS, HEAD_DIM)
        y_attn = sliding_window_attention(q, k, v, sinks[l], rel_bias) @ w_attn_branch[l]
        z = jax.nn.gelu(s5_ssm(u, lam_re[l], lam_im[l], log_dt[l], b_re[l], b_im[l],
                               c_re[l], c_im[l], d_skip[l]))
        z = z * jax.nn.sigmoid(z @ w_glu[l])
        y_ssm = z @ w_ssm_branch[l]
        merged = jax.nn.sigmoid(g_attn) * y_attn + jax.nn.sigmoid(g_ssm) * y_ssm
        x = x + rmsnorm(merged @ w_out[l], norm_mix_post[l])
        h = rmsnorm(x, norm_mlp_pre[l])
        f = jnp.square(jax.nn.relu(h @ w_ff_in[l])) @ w_ff_out[l]
        x = x + rmsnorm(f, norm_mlp_post[l])
    return x
```

```cpp
#include <hip/hip_runtime.h>
#include <math.h>

namespace {
constexpr int D = 1024, NB = 4, L = 4096;
constexpr int INW = 3328, AW = 512, SW = 512, DFF = 4096;
constexpr int OFF_K = 512, OFF_V = 640, OFF_U = 768, OFF_GA = 1280, OFF_GS = 2304;
constexpr float EPS = 1e-6f;

__device__ __forceinline__ float wave_sum(float v) {
#pragma unroll
    for (int o = 1; o < 64; o <<= 1) v += __shfl_xor(v, o);
    return v;
}
__device__ __forceinline__ float wave_max(float v) {
#pragma unroll
    for (int o = 1; o < 64; o <<= 1) v = fmaxf(v, __shfl_xor(v, o));
    return v;
}
__device__ __forceinline__ float sigmoidf_(float x) { return 1.0f / (1.0f + expf(-x)); }

__global__ __launch_bounds__(256) void k_rmsnorm(const float* __restrict__ in, const float* __restrict__ g, const float* __restrict__ res, float* __restrict__ out, int rows) {
    const int row = blockIdx.x * 4 + (threadIdx.x >> 6), lane = threadIdx.x & 63;
    if (row >= rows) return;
    const float* x = in + (size_t)row * D;
    float v[16]; float s = 0.f;
#pragma unroll
    for (int j = 0; j < 16; ++j) { v[j] = x[lane + 64 * j]; s += v[j] * v[j]; }
    s = wave_sum(s);
    const float r = 1.0f / sqrtf(s * (1.0f / D) + EPS);
#pragma unroll
    for (int j = 0; j < 16; ++j) { const int c = lane + 64 * j; float o = v[j] * r * g[c]; if (res) o += res[(size_t)row * D + c]; out[(size_t)row * D + c] = o; }
}

__global__ __launch_bounds__(256) void k_gemm(const float* __restrict__ A, int lda, const float* __restrict__ Bm, int ldb, float* __restrict__ C, int ldc, int K) {
    __shared__ float As[8][128];
    __shared__ float Bs[8][128];
    const int tid = threadIdx.x, tx = tid & 15, ty = tid >> 4;
    const int m0 = blockIdx.y * 128, n0 = blockIdx.x * 128;
    float acc[8][8];
#pragma unroll
    for (int i = 0; i < 8; ++i)
#pragma unroll
        for (int j = 0; j < 8; ++j) acc[i][j] = 0.f;
    for (int k0 = 0; k0 < K; k0 += 8) {
#pragma unroll
        for (int r = 0; r < 4; ++r) { const int i = tid + 256 * r; const int m = i >> 3, k = i & 7; As[k][m] = A[(size_t)(m0 + m) * lda + k0 + k]; }
#pragma unroll
        for (int r = 0; r < 4; ++r) { const int i = tid + 256 * r; const int k = i >> 7, n = i & 127; Bs[k][n] = Bm[(size_t)(k0 + k) * ldb + n0 + n]; }
        __syncthreads();
#pragma unroll
        for (int k = 0; k < 8; ++k) {
            float a[8], b[8];
#pragma unroll
            for (int i = 0; i < 8; ++i) a[i] = As[k][ty * 8 + i];
#pragma unroll
            for (int j = 0; j < 8; ++j) b[j] = Bs[k][tx * 8 + j];
#pragma unroll
            for (int i = 0; i < 8; ++i)
#pragma unroll
                for (int j = 0; j < 8; ++j) acc[i][j] += a[i] * b[j];
        }
        __syncthreads();
    }
#pragma unroll
    for (int i = 0; i < 8; ++i)
#pragma unroll
        for (int j = 0; j < 8; ++j) C[(size_t)(m0 + ty * 8 + i) * ldc + n0 + tx * 8 + j] = acc[i][j];
}

__device__ __forceinline__ int t5_bucket(int dist) {
    if (dist < 16) return dist;
    int large = 16 + (int)(logf((float)dist / 16.0f) / logf(8.0f) * 16.0f);
    return large < 31 ? large : 31;
}

__global__ __launch_bounds__(64) void k_attn(const float* __restrict__ proj, const float* __restrict__ rel_bias, const float* __restrict__ sinks, float* __restrict__ out) {
    const int t = blockIdx.x, h = blockIdx.y, lane = threadIdx.x, kvh = h >> 2;
    __shared__ float qs[64];
    __shared__ float ps[128];
    qs[lane] = proj[(size_t)t * INW + h * 64 + lane];
    __syncthreads();
    const float sink = sinks[h];
    float lg[2];
#pragma unroll
    for (int r = 0; r < 2; ++r) {
        const int dist = lane + 64 * r, kp = t - dist;
        float v = -1e30f;
        if (kp >= 0) {
            const float* kr = proj + (size_t)kp * INW + OFF_K + kvh * 64;
            float s = 0.f;
            for (int d = 0; d < 64; ++d) s += qs[d] * kr[d];
            v = s * 0.125f + rel_bias[t5_bucket(dist) * 8 + h];
        }
        lg[r] = v;
    }
    float m = wave_max(fmaxf(lg[0], lg[1]));
    m = fmaxf(m, sink);
    const float p0 = expf(lg[0] - m), p1 = expf(lg[1] - m);
    const float den = wave_sum(p0 + p1) + expf(sink - m);
    ps[lane] = p0 / den; ps[lane + 64] = p1 / den;
    __syncthreads();
    float o = 0.f;
    for (int dist = 0; dist < 128; ++dist) { const int kp = t - dist; if (kp < 0) break; o += ps[dist] * proj[(size_t)kp * INW + OFF_V + kvh * 64 + lane]; }
    out[(size_t)t * AW + h * 64 + lane] = o;
}

__device__ __forceinline__ float gelu_tanh(float y) { return 0.5f * y * (1.0f + tanhf(0.7978845608028654f * (y + 0.044715f * y * y * y))); }

__global__ __launch_bounds__(64) void k_ssm(const float* __restrict__ proj, const float* __restrict__ lam_re, const float* __restrict__ lam_im, const float* __restrict__ log_dt,
                                            const float* __restrict__ b_re, const float* __restrict__ b_im, const float* __restrict__ c_re, const float* __restrict__ c_im,
                                            const float* __restrict__ d_skip, float* __restrict__ z) {
    const int g = blockIdx.x, p = threadIdx.x;
    const float dt = expf(log_dt[g]);
    const float lr = lam_re[g * 64 + p], li = lam_im[g * 64 + p];
    const float mag = expf(lr * dt);
    const float abr = mag * cosf(li * dt), abi = mag * sinf(li * dt);
    const float nr = abr - 1.0f, den = lr * lr + li * li;
    const float fr = (nr * lr + abi * li) / den, fi = (abi * lr - nr * li) / den;
    float bbr[16], bbi[16], cr[16], ci[16];
#pragma unroll
    for (int c = 0; c < 16; ++c) {
        const float br = b_re[(size_t)(g * 64 + p) * 16 + c], bi = b_im[(size_t)(g * 64 + p) * 16 + c];
        bbr[c] = fr * br - fi * bi; bbi[c] = fr * bi + fi * br;
        cr[c] = c_re[(size_t)(g * 16 + c) * 64 + p]; ci[c] = c_im[(size_t)(g * 16 + c) * 64 + p];
    }
    const float dsk = d_skip[g * 16 + (p & 15)];
    float hr = 0.f, hi = 0.f;
    for (int t = 0; t < L; ++t) {
        const float* u = proj + (size_t)t * INW + OFF_U + g * 16;
        float bur = 0.f, bui = 0.f, umine = 0.f;
#pragma unroll
        for (int c = 0; c < 16; ++c) { const float uv = u[c]; bur += bbr[c] * uv; bui += bbi[c] * uv; umine = ((p & 15) == c) ? uv : umine; }
        const float nhr = abr * hr - abi * hi + bur, nhi = abr * hi + abi * hr + bui;
        hr = nhr; hi = nhi;
        float ymine = 0.f;
#pragma unroll
        for (int c = 0; c < 16; ++c) { const float y = wave_sum(cr[c] * hr - ci[c] * hi); ymine = (p == c) ? y : ymine; }
        if (p < 16) z[(size_t)t * SW + g * 16 + p] = gelu_tanh(ymine + dsk * umine);
    }
}

__global__ __launch_bounds__(256) void k_glu(const float* __restrict__ zz, float* __restrict__ t, size_t n) {
    const size_t i = (size_t)blockIdx.x * 256 + threadIdx.x; if (i < n) t[i] = zz[i] * sigmoidf_(t[i]);
}
__global__ __launch_bounds__(256) void k_merge(const float* __restrict__ proj, const float* __restrict__ ya, const float* __restrict__ ys, float* __restrict__ mg, int rows) {
    const size_t i = (size_t)blockIdx.x * 256 + threadIdx.x; if (i >= (size_t)rows * D) return;
    const size_t r = i / D; const int c = (int)(i % D);
    mg[i] = sigmoidf_(proj[r * INW + OFF_GA + c]) * ya[i] + sigmoidf_(proj[r * INW + OFF_GS + c]) * ys[i];
}
__global__ __launch_bounds__(256) void k_relu2(float* __restrict__ f, size_t n) {
    const size_t i = (size_t)blockIdx.x * 256 + threadIdx.x; if (i < n) { const float v = fmaxf(f[i], 0.f); f[i] = v * v; }
}
}

extern "C" void kernel_launch(void* const* d_in, const int* in_sizes, int n_in, void* d_out, int out_size, void* d_ws, size_t ws_size, hipStream_t stream) {
    const float* x = (const float*)d_in[0];
    const float *g_pre = (const float*)d_in[1], *g_post = (const float*)d_in[2], *g_mpre = (const float*)d_in[3], *g_mpost = (const float*)d_in[4];
    const float *w_in = (const float*)d_in[5], *rel_bias = (const float*)d_in[6], *sinks = (const float*)d_in[7];
    const float *lam_re = (const float*)d_in[8], *lam_im = (const float*)d_in[9], *log_dt = (const float*)d_in[10];
    const float *b_re = (const float*)d_in[11], *b_im = (const float*)d_in[12], *c_re = (const float*)d_in[13], *c_im = (const float*)d_in[14], *d_skip = (const float*)d_in[15];
    const float *w_glu = (const float*)d_in[16], *w_ab = (const float*)d_in[17], *w_sb = (const float*)d_in[18], *w_out = (const float*)d_in[19], *w_ff1 = (const float*)d_in[20], *w_ff2 = (const float*)d_in[21];
    float* out = (float*)d_out;
    const size_t MiB = 1u << 20;
    char* ws = (char*)d_ws;
    float* R0 = (float*)(ws + 0 * MiB);
    float* R1 = (float*)(ws + 16 * MiB);
    float* R2 = (float*)(ws + 80 * MiB);
    float* R3 = (float*)(ws + 88 * MiB);
    float* R4 = (float*)(ws + 96 * MiB);
    float* R5 = (float*)(ws + 104 * MiB);
    float* R6 = (float*)(ws + 120 * MiB);
    float* R7 = (float*)(ws + 136 * MiB);
    float* R8 = (float*)(ws + 152 * MiB);
    for (int b = 0; b < NB; ++b) {
        const float* xb = x + (size_t)b * L * D; float* ob = out + (size_t)b * L * D;
        k_rmsnorm<<<L / 4, 256, 0, stream>>>(xb, g_pre, nullptr, R0, L);
        k_gemm<<<dim3(INW / 128, L / 128), 256, 0, stream>>>(R0, D, w_in, INW, R1, INW, D);
        k_attn<<<dim3(L, 8), 64, 0, stream>>>(R1, rel_bias, sinks, R2);
        k_ssm<<<32, 64, 0, stream>>>(R1, lam_re, lam_im, log_dt, b_re, b_im, c_re, c_im, d_skip, R3);
        k_gemm<<<dim3(SW / 128, L / 128), 256, 0, stream>>>(R3, SW, w_glu, SW, R4, SW, SW);
        k_glu<<<(L * SW) / 256, 256, 0, stream>>>(R3, R4, (size_t)L * SW);
        k_gemm<<<dim3(D / 128, L / 128), 256, 0, stream>>>(R2, AW, w_ab, D, R5, D, AW);
        k_gemm<<<dim3(D / 128, L / 128), 256, 0, stream>>>(R4, SW, w_sb, D, R7, D, SW);
        k_merge<<<(L * D) / 256, 256, 0, stream>>>(R1, R5, R7, R6, L);
        k_gemm<<<dim3(D / 128, L / 128), 256, 0, stream>>>(R6, D, w_out, D, R5, D, D);
        k_rmsnorm<<<L / 4, 256, 0, stream>>>(R5, g_post, xb, R8, L);
        k_rmsnorm<<<L / 4, 256, 0, stream>>>(R8, g_mpre, nullptr, R0, L);
        k_gemm<<<dim3(DFF / 128, L / 128), 256, 0, stream>>>(R0, D, w_ff1, DFF, R1, DFF, D);
        k_relu2<<<(L * DFF) / 256, 256, 0, stream>>>(R1, (size_t)L * DFF);
        k_gemm<<<dim3(D / 128, L / 128), 256, 0, stream>>>(R1, DFF, w_ff2, D, R7, D, DFF);
        k_rmsnorm<<<L / 4, 256, 0, stream>>>(R7, g_mpost, R8, ob, L);
    }
}
```

```cpp
#include <hip/hip_runtime.h>
#include <cstdio>
#include <cstdint>
#include <cmath>
namespace pg8 {
#define PG8_LAS __attribute__((address_space(3)))
typedef unsigned short bf16_t;
typedef short bf16x8 __attribute__((ext_vector_type(8)));
typedef float f32x4 __attribute__((ext_vector_type(4)));
typedef unsigned u32x4 __attribute__((ext_vector_type(4)));
constexpr int BM = 256, BK = 64, HALF = 128, HTB = HALF * BK * 2  , STAGE_BYTES = 8 * HTB, NXCD = 8, WGM = 8;

__host__ __device__ __forceinline__ int lds_byte(int r, int c) { const int st = (r >> 4) * 2 + (c >> 5), rr = r & 15, cc = c & 31, ob = rr * 64 + cc * 2; return st * 1024 + (ob ^ (((ob >> 9) & 1) << 5)); }
__host__ __device__ __forceinline__ void stage_rc(int b, int& R, int& C) { const int st = b / 1024, sb = b % 1024, swz = sb ^ (((sb >> 9) & 1) << 5); R = (st >> 1) * 16 + swz / 64; C = (st & 1) * 32 + (swz % 64) / 2; }
__host__ __device__ __forceinline__ int perm32(int rho) { const int n = rho >> 4, i = rho & 15; return 8 * (i >> 2) + 4 * n + (i & 3); }

struct Unit { int pm, pn; };
struct Gemm { const bf16_t* A; const bf16_t* Bt; int M, N, K; };

struct StaticOrder {
    int nM, nN, nwg, G, c;
    __host__ __device__ void init(int M, int N, int G_, int c_) { nM = M / BM; nN = N / BM; nwg = nM * nN; G = G_; c = c_; }
    __host__ __device__ bool next(int i, Unit& u) const {
        const long L = (long)i * G + c; if (L >= nwg) return false;
        int wgid = (int)L; { const int q = nwg / NXCD, r = nwg % NXCD, xcd = wgid % NXCD, off = wgid / NXCD; wgid = (xcd < r ? xcd * (q + 1) : r * (q + 1) + (xcd - r) * q) + off; }
        const int nig = WGM * nN, gid = wgid / nig, fm = gid * WGM, gsz = (nM - fm) < WGM ? (nM - fm) : WGM;
        u.pm = fm + ((wgid % nig) % gsz); u.pn = (wgid % nig) / gsz; return true;
    }
    __device__ __forceinline__ void a_ready(const Unit&) const {}
    __device__ __forceinline__ void done(const Unit&) const {}
};
__device__ __forceinline__ unsigned cvt_pk_bf16(float lo, float hi) { unsigned r; asm volatile("v_cvt_pk_bf16_f32 %0, %1, %2" : "=v"(r) : "v"(lo), "v"(hi)); return r; }
typedef float f32x2 __attribute__((ext_vector_type(2)));
__device__ __forceinline__ float bf_lo(unsigned w) { return __uint_as_float(w << 16); }
__device__ __forceinline__ float bf_hi(unsigned w) { return __uint_as_float(w & 0xffff0000u); }
__device__ __forceinline__ float fast_sigmoid(float x) { return __builtin_amdgcn_rcpf(1.0f + __builtin_amdgcn_exp2f(-1.4426950408889634f * x)); }
__device__ __forceinline__ u32x4 pack8(f32x4 v0, f32x4 v1) { u32x4 w; w.x = cvt_pk_bf16(v0[0], v0[1]); w.y = cvt_pk_bf16(v0[2], v0[3]); w.z = cvt_pk_bf16(v1[0], v1[1]); w.w = cvt_pk_bf16(v1[2], v1[3]); return w; }
__device__ __forceinline__ void unpack8(u32x4 w, f32x4& v0, f32x4& v1) { v0 = (f32x4){bf_lo(w.x), bf_hi(w.x), bf_lo(w.y), bf_hi(w.y)}; v1 = (f32x4){bf_lo(w.z), bf_hi(w.z), bf_lo(w.w), bf_hi(w.w)}; }
__device__ __forceinline__ f32x4 sig4(f32x4 v) { return (f32x4){fast_sigmoid(v[0]), fast_sigmoid(v[1]), fast_sigmoid(v[2]), fast_sigmoid(v[3])}; }

struct EpiProj {
    static constexpr bool PERM = true, AFTER_DRAIN = false;
    bf16_t *Q, *KV, *U, *GA, *GS;
    __device__ __forceinline__ void operator()(const f32x4 (&acc)[2][2][4][2], const Unit& u, int wr, int wc, int fr, int fq) const {
        const int pn = u.pn; bf16_t* base; int ldc, colt, mode;
        if (pn < 2) { base = Q; ldc = 512; colt = pn * 256; mode = 1; }
        else if (pn == 2) { base = KV; ldc = 256; colt = 0; mode = 0; }
        else if (pn < 5) { base = U; ldc = 512; colt = (pn - 3) * 256; mode = 0; }
        else if (pn < 9) { base = GA; ldc = 1024; colt = (pn - 5) * 256; mode = 2; }
        else { base = GS; ldc = 1024; colt = (pn - 9) * 256; mode = 2; }
        const int row0 = u.pm * BM + wr * 64 + fr, col0 = colt + wc * 32 + 8 * fq;
#pragma unroll
        for (int ai = 0; ai < 2; ++ai)
#pragma unroll
            for (int m = 0; m < 4; ++m) { bf16_t* rowp = base + (size_t)(row0 + ai * HALF + m * 16) * ldc + col0;
#pragma unroll
                for (int bj = 0; bj < 2; ++bj) { f32x4 v0 = acc[ai][bj][m][0], v1 = acc[ai][bj][m][1];
                    if (mode == 1) { v0 = v0 * 0.125f; v1 = v1 * 0.125f; }
                    if (mode == 2) { v0 = sig4(v0); v1 = sig4(v1); }
                    *(u32x4*)(rowp + bj * HALF) = pack8(v0, v1); } }
    }
};
struct EpiGlu {
    static constexpr bool PERM = true, AFTER_DRAIN = false;
    const bf16_t* Z; bf16_t* Z2;
    __device__ __forceinline__ void operator()(const f32x4 (&acc)[2][2][4][2], const Unit& u, int wr, int wc, int fr, int fq) const {
        const int row0 = u.pm * BM + wr * 64 + fr, col0 = u.pn * BM + wc * 32 + 8 * fq;
#pragma unroll
        for (int ai = 0; ai < 2; ++ai)
#pragma unroll
            for (int m = 0; m < 4; ++m) { const size_t off = (size_t)(row0 + ai * HALF + m * 16) * 512 + col0;
#pragma unroll
                for (int bj = 0; bj < 2; ++bj) { f32x4 z0, z1; unpack8(*(const u32x4*)(Z + off + bj * HALF), z0, z1);
                    *(u32x4*)(Z2 + off + bj * HALF) = pack8(z0 * sig4(acc[ai][bj][m][0]), z1 * sig4(acc[ai][bj][m][1])); } }
    }
};
struct EpiGate {
    static constexpr bool PERM = true, AFTER_DRAIN = false;
    const bf16_t* gate; const bf16_t* addend; bf16_t* O;
    __device__ __forceinline__ void operator()(const f32x4 (&acc)[2][2][4][2], const Unit& u, int wr, int wc, int fr, int fq) const {
        const int row0 = u.pm * BM + wr * 64 + fr, col0 = u.pn * BM + wc * 32 + 8 * fq;
#pragma unroll
        for (int ai = 0; ai < 2; ++ai)
#pragma unroll
            for (int m = 0; m < 4; ++m) { const size_t off = (size_t)(row0 + ai * HALF + m * 16) * 1024 + col0;
#pragma unroll
                for (int bj = 0; bj < 2; ++bj) { f32x4 g0, g1; unpack8(*(const u32x4*)(gate + off + bj * HALF), g0, g1);
                    f32x4 v0 = g0 * acc[ai][bj][m][0], v1 = g1 * acc[ai][bj][m][1];
                    if (addend) { f32x4 a0, a1; unpack8(*(const u32x4*)(addend + off + bj * HALF), a0, a1); v0 = v0 + a0; v1 = v1 + a1; }
                    *(u32x4*)(O + off + bj * HALF) = pack8(v0, v1); } }
    }
};
struct EpiF32 {
    static constexpr bool PERM = false, AFTER_DRAIN = false;
    float* C; int ldc;
    __device__ __forceinline__ void operator()(const f32x4 (&acc)[2][2][4][2], const Unit& u, int wr, int wc, int fr, int fq) const {
        const int row0 = u.pm * BM + wr * 64 + fr, col0 = u.pn * BM + wc * 32 + 4 * fq;
#pragma unroll
        for (int ai = 0; ai < 2; ++ai)
#pragma unroll
            for (int m = 0; m < 4; ++m) { float* rowp = C + (size_t)(row0 + ai * HALF + m * 16) * ldc + col0;
#pragma unroll
                for (int bj = 0; bj < 2; ++bj)
#pragma unroll
                    for (int n = 0; n < 2; ++n) *(f32x4*)(rowp + bj * HALF + n * 16) = acc[ai][bj][m][n]; }
    }
};
struct EpiRelu2 {
    static constexpr bool PERM = true, AFTER_DRAIN = false;
    bf16_t* O; int ldc;
    __device__ __forceinline__ void operator()(const f32x4 (&acc)[2][2][4][2], const Unit& u, int wr, int wc, int fr, int fq) const {
        const int row0 = u.pm * BM + wr * 64 + fr, col0 = u.pn * BM + wc * 32 + 8 * fq;
#pragma unroll
        for (int ai = 0; ai < 2; ++ai)
#pragma unroll
            for (int m = 0; m < 4; ++m) { bf16_t* rowp = O + (size_t)(row0 + ai * HALF + m * 16) * ldc + col0;
#pragma unroll
                for (int bj = 0; bj < 2; ++bj) { f32x4 v0 = acc[ai][bj][m][0], v1 = acc[ai][bj][m][1];
#pragma unroll
                    for (int j = 0; j < 4; ++j) { const float a = fmaxf(v0[j], 0.f), b = fmaxf(v1[j], 0.f); v0[j] = a * a; v1[j] = b * b; }
                    *(u32x4*)(rowp + bj * HALF) = pack8(v0, v1); } }
    }
};

template <class Epi, class Sched, bool ALIGN_EPI = false, bool SP2 = false>
__device__ __forceinline__ void gemm_phase(PG8_LAS unsigned char* lds, const Gemm g, const Sched& S, const Epi& E) {
    const int tid = threadIdx.x, wid = __builtin_amdgcn_readfirstlane(tid >> 6), lane = tid & 63, wr = wid >> 2, wc = wid & 3, fr = lane & 15, fq = lane >> 4;
    const int K = g.K, nt = K / BK;
    unsigned voffA[2], voffB[2];
#pragma unroll
    for (int i = 0; i < 2; ++i) { int R, C; stage_rc(tid * 16 + i * 8192, R, C); const int Rb = Epi::PERM ? ((R & ~31) + perm32(R & 31)) : R;
        voffA[i] = (unsigned)(R * K + C) * 2u; voffB[i] = (unsigned)(Rb * K + C) * 2u; }
    const size_t kstep = (size_t)(BK * 2);
    const size_t hstep = (size_t)HALF * K * 2;
    const size_t tstep = 2 * hstep;
    const unsigned ldsw = (unsigned)wid * 1024u;
    const int aoff = lds_byte(wr * 64 + fr, fq * 8), boff = lds_byte(wc * 32 + fr, fq * 8);
#define PG8_SA(b, h) (((b) * 2 + (h)) * HTB)
#define PG8_SB(b, h) ((4 + (b) * 2 + (h)) * HTB)
#define PG8_STAGE(bufoff, gbase, voff) do { _Pragma("unroll") for (int _i = 0; _i < 2; ++_i) \
        __builtin_amdgcn_global_load_lds((const unsigned*)((const char*)(gbase) + (voff)[_i]), (PG8_LAS unsigned*)(lds + (bufoff) + ldsw + _i * 8192), 16, 0, 0); } while (0)
#define PG8_LDA(dst, b, h) do { _Pragma("unroll") for (int m = 0; m < 4; ++m) _Pragma("unroll") for (int k = 0; k < 2; ++k) dst[m][k] = *(const PG8_LAS bf16x8*)(lds + PG8_SA(b, h) + aoff + m * 2048 + k * 1024); } while (0)
#define PG8_LDB(dst, b, h) do { _Pragma("unroll") for (int n = 0; n < 2; ++n) _Pragma("unroll") for (int k = 0; k < 2; ++k) dst[n][k] = *(const PG8_LAS bf16x8*)(lds + PG8_SB(b, h) + boff + n * 2048 + k * 1024); } while (0)
#define PG8_MMA(ai, bj, At, Bt) do { __builtin_amdgcn_s_setprio(1); _Pragma("unroll") for (int m = 0; m < 4; ++m) _Pragma("unroll") for (int n = 0; n < 2; ++n) _Pragma("unroll") for (int k = 0; k < 2; ++k) \
        acc[ai][bj][m][n] = __builtin_amdgcn_mfma_f32_16x16x32_bf16(Bt[n][k], At[m][k], acc[ai][bj][m][n], 0, 0, 0); __builtin_amdgcn_s_setprio(0); } while (0)
#define PG8_WAIT_V(n) asm volatile("s_waitcnt vmcnt(" #n ")" ::: "memory")
#define PG8_WAIT_L(n) asm volatile("s_waitcnt lgkmcnt(" #n ")" ::: "memory")
#define PG8_BAR __builtin_amdgcn_s_barrier()
#define PG8_SCHED __builtin_amdgcn_sched_barrier(0)
    Unit cur, nxt; int ui = 0;
    if (!S.next(0, cur)) return;
    f32x4 acc[2][2][4][2];
#pragma unroll
    for (int a = 0; a < 2; ++a)
#pragma unroll
        for (int b = 0; b < 2; ++b)
#pragma unroll
            for (int m = 0; m < 4; ++m)
#pragma unroll
                for (int n = 0; n < 2; ++n) acc[a][b][m][n] = (f32x4){0.f, 0.f, 0.f, 0.f};
    bf16x8 At[4][2], B0[2][2], B1[2][2];
    const char* cA = (const char*)g.A + (size_t)cur.pm * tstep; const char* cB = (const char*)g.Bt + (size_t)cur.pn * tstep;
    S.a_ready(cur);
    if constexpr (SP2) {
        PG8_STAGE(PG8_SB(0, 0), cB, voffB); PG8_STAGE(PG8_SB(0, 1), cB + hstep, voffB); PG8_STAGE(PG8_SA(0, 0), cA, voffA); PG8_STAGE(PG8_SA(0, 1), cA + hstep, voffA);
        if (wr == 1) PG8_BAR;
        PG8_WAIT_V(2); PG8_BAR;
        PG8_STAGE(PG8_SB(1, 0), cB + kstep, voffB); PG8_STAGE(PG8_SA(1, 0), cA + kstep, voffA); PG8_STAGE(PG8_SB(1, 1), cB + hstep + kstep, voffB);
        PG8_WAIT_V(6); PG8_BAR;
    } else {
        PG8_STAGE(PG8_SB(0, 0), cB, voffB); PG8_STAGE(PG8_SA(0, 0), cA, voffA); PG8_STAGE(PG8_SB(0, 1), cB + hstep, voffB); PG8_STAGE(PG8_SA(0, 1), cA + hstep, voffA);
        if (wr == 1) PG8_BAR;
        PG8_WAIT_V(4); PG8_BAR;
        PG8_STAGE(PG8_SB(1, 0), cB + kstep, voffB); PG8_STAGE(PG8_SA(1, 0), cA + kstep, voffA); PG8_STAGE(PG8_SB(1, 1), cB + hstep + kstep, voffB);
        PG8_WAIT_V(6); PG8_BAR;
    }
    for (;;) {
        const bool has_next = S.next(ui + 1, nxt);
        const char* nA = has_next ? (const char*)g.A + (size_t)nxt.pm * tstep : cA; const char* nB = has_next ? (const char*)g.Bt + (size_t)nxt.pn * tstep : cB;
        for (int t = 0; t < nt; t += 2) {
            const bool last = (t == nt - 2);
            const char* a1 = cA + (size_t)(t + 1) * kstep;
            const char* a2 = last ? nA : cA + (size_t)(t + 2) * kstep; const char* b2 = last ? nB : cB + (size_t)(t + 2) * kstep;
            const char* a3 = a2 + kstep; const char* b3 = b2 + kstep;
            if (last && has_next) S.a_ready(nxt);
            if constexpr (SP2) {
            PG8_LDB(B0, 0, 0); PG8_LDB(B1, 0, 1); PG8_SCHED; PG8_LDA(At, 0, 0); PG8_STAGE(PG8_SA(1, 1), a1 + hstep, voffA);
            PG8_WAIT_V(8); PG8_WAIT_L(0); PG8_BAR; PG8_MMA(0, 0, At, B0); PG8_MMA(0, 1, At, B1); PG8_BAR; PG8_SCHED;
            PG8_LDA(At, 0, 1); PG8_STAGE(PG8_SB(0, 0), b2, voffB); PG8_STAGE(PG8_SB(0, 1), b2 + hstep, voffB); PG8_STAGE(PG8_SA(0, 0), a2, voffA);
            PG8_WAIT_V(8); PG8_WAIT_L(0); PG8_BAR; PG8_MMA(1, 0, At, B0); PG8_MMA(1, 1, At, B1); PG8_BAR; PG8_SCHED;
            PG8_LDB(B0, 1, 0); PG8_LDB(B1, 1, 1); PG8_SCHED; PG8_LDA(At, 1, 0); PG8_STAGE(PG8_SA(0, 1), a2 + hstep, voffA);
            PG8_WAIT_V(8); PG8_WAIT_L(0); PG8_BAR; PG8_MMA(0, 0, At, B0); PG8_MMA(0, 1, At, B1); PG8_BAR; PG8_SCHED;
            PG8_LDA(At, 1, 1); PG8_STAGE(PG8_SB(1, 0), b3, voffB); PG8_STAGE(PG8_SB(1, 1), b3 + hstep, voffB); PG8_STAGE(PG8_SA(1, 0), a3, voffA);
            PG8_WAIT_V(8); PG8_WAIT_L(0); PG8_BAR; PG8_MMA(1, 0, At, B0); PG8_MMA(1, 1, At, B1); PG8_BAR; PG8_SCHED;
            } else {
            PG8_LDB(B0, 0, 0); PG8_SCHED; PG8_LDA(At, 0, 0); PG8_STAGE(PG8_SA(1, 1), a1 + hstep, voffA);
            PG8_WAIT_L(8); PG8_BAR; PG8_WAIT_L(0); PG8_MMA(0, 0, At, B0); PG8_BAR; PG8_SCHED;
            PG8_LDB(B1, 0, 1); PG8_STAGE(PG8_SB(0, 0), b2, voffB);
            PG8_BAR; PG8_WAIT_L(0); PG8_MMA(0, 1, At, B1); PG8_BAR;
            PG8_LDA(At, 0, 1); PG8_STAGE(PG8_SA(0, 0), a2, voffA);
            PG8_BAR; PG8_WAIT_L(0); PG8_MMA(1, 0, At, B0); PG8_BAR; PG8_SCHED;
            PG8_STAGE(PG8_SB(0, 1), b2 + hstep, voffB);
            PG8_WAIT_V(6); PG8_BAR; PG8_MMA(1, 1, At, B1); PG8_BAR;
            PG8_LDB(B0, 1, 0); PG8_SCHED; PG8_LDA(At, 1, 0); PG8_STAGE(PG8_SA(0, 1), a2 + hstep, voffA);
            PG8_WAIT_L(8); PG8_BAR; PG8_WAIT_L(0); PG8_MMA(0, 0, At, B0); PG8_BAR; PG8_SCHED;
            PG8_LDB(B1, 1, 1); PG8_STAGE(PG8_SB(1, 0), b3, voffB);
            PG8_BAR; PG8_WAIT_L(0); PG8_MMA(0, 1, At, B1); PG8_BAR;
            PG8_LDA(At, 1, 1); PG8_STAGE(PG8_SA(1, 0), a3, voffA);
            PG8_BAR; PG8_WAIT_L(0); PG8_MMA(1, 0, At, B0); PG8_BAR; PG8_SCHED;
            PG8_STAGE(PG8_SB(1, 1), b3 + hstep, voffB);
            PG8_WAIT_V(6); PG8_BAR; PG8_MMA(1, 1, At, B1); PG8_BAR;
            }
        }
        if constexpr (ALIGN_EPI) { if (wr == 0) PG8_BAR; }
        if constexpr (!Epi::AFTER_DRAIN) { E(acc, cur, wr, wc, fr, fq); S.done(cur); }
        if (!has_next) break;
#pragma unroll
        for (int a = 0; a < 2; ++a)
#pragma unroll
            for (int b = 0; b < 2; ++b)
#pragma unroll
                for (int m = 0; m < 4; ++m)
#pragma unroll
                    for (int n = 0; n < 2; ++n) acc[a][b][m][n] = (f32x4){0.f, 0.f, 0.f, 0.f};
        cur = nxt; cA = nA; cB = nB; ++ui;
        if constexpr (ALIGN_EPI) { if (wr == 1) PG8_BAR; }
    }
    PG8_WAIT_V(0);
    if constexpr (!ALIGN_EPI) { if (wr == 0) PG8_BAR; }
    PG8_BAR;
    if constexpr (Epi::AFTER_DRAIN) { E.fused(acc, cur, wr, wc, fr, fq, lds, wid, lane); S.done(cur); }
#undef PG8_SA
#undef PG8_SB
#undef PG8_STAGE
#undef PG8_LDA
#undef PG8_LDB
#undef PG8_MMA
#undef PG8_WAIT_V
#undef PG8_WAIT_L
#undef PG8_BAR
#undef PG8_SCHED
}
}
constexpr int NWAVES = 8;
constexpr int NB = 4, SEQ = 4096, M = NB * SEQ, D = 1024, INW = 3328, DFF = 4096;
constexpr int TCH = 64, NCH = SEQ / TCH;
constexpr float RMS_EPS = 1e-6f;
constexpr size_t MiB = 1u << 20;
constexpr size_t WS_CTL = 0, CTL_ZERO_BYTES = 64 * 1024;
constexpr size_t WS_WIN = 1 * MiB, WS_WGLU = 8 * MiB, WS_WAB = 9 * MiB, WS_WSB = 10 * MiB, WS_WOUT = 11 * MiB, WS_WFF1 = 13 * MiB, WS_WFF2 = 21 * MiB;
constexpr size_t WS_XN = 30 * MiB;
constexpr size_t WS_Q = 62 * MiB, WS_KV = 78 * MiB, WS_U = 86 * MiB, WS_GA = 102 * MiB, WS_GS = 134 * MiB, WS_ATT = 166 * MiB, WS_Z = 182 * MiB, WS_Z2 = 198 * MiB, WS_YA = 214 * MiB;
constexpr size_t WS_S = 246 * MiB;
constexpr size_t WS_MG = 62 * MiB;
constexpr size_t WS_O = 102 * MiB;
constexpr size_t WS_F1 = 62 * MiB;
constexpr size_t WS_F2 = 190 * MiB;
constexpr size_t WS_END = 254 * MiB;
constexpr int CW_BAR = 4096;
constexpr int RING_BYTES = 131072, LDSCTL_OFF = RING_BYTES, MISC_OFF = LDSCTL_OFF + 320, LDS_BYTES = 147456;

#define GAS __attribute__((address_space(1)))
#define LAS __attribute__((address_space(3)))
typedef unsigned short bf16;
typedef unsigned v4u __attribute__((ext_vector_type(4)));
typedef float f32x4 __attribute__((ext_vector_type(4)));
__device__ __forceinline__ unsigned f2bf(float f) { unsigned u = __builtin_bit_cast(unsigned, f); return (u + 0x7fffu + ((u >> 16) & 1u)) >> 16; }
__device__ __forceinline__ unsigned pk2(float lo, float hi) { return f2bf(lo) | (f2bf(hi) << 16); }
__device__ __forceinline__ float bf2f(bf16 v) { return __uint_as_float((unsigned)v << 16); }
__device__ __forceinline__ float wave_sum(float v) {
#pragma unroll
    for (int o = 1; o < 64; o <<= 1) v += __shfl_xor(v, o);
    return v;
}
__device__ __forceinline__ float wave_max(float v) {
#pragma unroll
    for (int o = 1; o < 64; o <<= 1) v = fmaxf(v, __shfl_xor(v, o));
    return v;
}
#define XB_TMO      128
#define XB_XCNT(j)  (256  + 64 * (j))
#define XB_XSUB(j)  (1280 + 64 * (j))
#define XB_XGEN(j)  (2304 + 64 * (j))
#define XB_TOP      3328
#define XB_TOPGEN   3392
#define XCD_BAR_WORDS 3456
#define XB_SPIN_CAP (1u << 18)

__device__ __forceinline__ unsigned xb_ld(unsigned* p)              { return __hip_atomic_load(p, __ATOMIC_RELAXED, __HIP_MEMORY_SCOPE_AGENT); }
__device__ __forceinline__ unsigned xb_add(unsigned* p, unsigned v) { return __hip_atomic_fetch_add(p, v, __ATOMIC_RELAXED, __HIP_MEMORY_SCOPE_AGENT); }
__device__ __forceinline__ unsigned xb_xcc_id() { return (unsigned)__builtin_amdgcn_s_getreg((3 << 11) | 20) & 0xFu; }
#define XB_SPIN(cond, bar) do { unsigned _sp = 0; while (cond) { __builtin_amdgcn_s_sleep(1); \
    if ((++_sp & 255u) == 0u) { if (xb_ld(&(bar)[XB_TMO])) break; if (_sp > XB_SPIN_CAP) { atomicAdd(&(bar)[XB_TMO], 1u); break; } } } } while (0)

struct XcdBarrier {
    unsigned* bar; unsigned x;
    volatile LAS unsigned* st;
};

__device__ __forceinline__ XcdBarrier xcd_barrier_post(unsigned* bar, volatile LAS unsigned* st) {
    XcdBarrier b; b.bar = bar; b.x = xb_xcc_id(); b.st = st;
    if (threadIdx.x == 0) (void)xb_add(&bar[XB_XCNT(b.x)], 1u);
    return b;
}
__device__ __forceinline__ void xcd_barrier_complete(unsigned* bar, unsigned x, unsigned& nloc, unsigned& nx) {
    const unsigned G = gridDim.x * gridDim.y * gridDim.z;
    unsigned sum, cnt, mine, sp = 0u;
    for (;;) {
        sum = 0u; cnt = 0u; mine = 0u;
#pragma unroll
        for (unsigned j = 0; j < 16; ++j) { const unsigned c = xb_ld(&bar[XB_XCNT(j)]); sum += c; cnt += (c > 0u) ? 1u : 0u; mine = (j == x) ? c : mine; }
        if (sum == G) break;
        __builtin_amdgcn_s_sleep(1);
        if ((++sp & 255u) == 0u) { if (xb_ld(&bar[XB_TMO])) break; if (sp > XB_SPIN_CAP) { atomicAdd(&bar[XB_TMO], 1u); break; } }
    }
    nloc = mine > 0u ? mine : 1u; nx = cnt > 0u ? cnt : 1u;
}

__device__ __forceinline__ void xcd_barrier(const XcdBarrier& b) {
    asm volatile("s_waitcnt vmcnt(0)" ::: "memory");
    __syncthreads();
    if (threadIdx.x == 0) {
        unsigned* bar = b.bar;
        __builtin_amdgcn_s_waitcnt(0);
        unsigned nloc = b.st[0], nx = b.st[1];
        if (nloc == 0u) { xcd_barrier_complete(bar, b.x, nloc, nx); b.st[0] = nloc; b.st[1] = nx; }
        const unsigned old = xb_add(&bar[XB_XSUB(b.x)], 1u);
        const unsigned gen = old / nloc;
        if (old + 1u == (gen + 1u) * nloc) {
            __builtin_amdgcn_fence(__ATOMIC_RELEASE, "agent");
            asm volatile("s_waitcnt vmcnt(0)" ::: "memory");
            const unsigned og = xb_add(&bar[XB_TOP], 1u);
            const unsigned tg = og / nx;
            if (og + 1u == (tg + 1u) * nx) xb_add(&bar[XB_TOPGEN], 1u);
            else XB_SPIN(xb_ld(&bar[XB_TOPGEN]) == tg, bar);
            __builtin_amdgcn_fence(__ATOMIC_ACQUIRE, "agent");
            xb_add(&bar[XB_XGEN(b.x)], 1u);
            asm volatile("s_waitcnt vmcnt(0)" ::: "memory");
        } else {
            XB_SPIN(xb_ld(&bar[XB_XGEN(b.x)]) == gen, bar);
            __builtin_amdgcn_fence(__ATOMIC_ACQUIRE, "agent");
            asm volatile("s_waitcnt vmcnt(0)" ::: "memory");
        }
    }
    __syncthreads();
}
__device__ __forceinline__ void p0_transpose_item(const float* W, const float* gk, int K, int N, bf16* WT, LAS float* scr, int item, int lane) {
    const int nblk = N / 32, kb = item / nblk, nb = item % nblk, k0 = 64 * kb, n0 = 32 * nb;
#pragma unroll 8
    for (int i = 0; i < 32; ++i) { const int kk = 2 * i + (lane >> 5); float w = W[(size_t)(k0 + kk) * N + n0 + (lane & 31)]; if (gk) w *= gk[k0 + kk]; scr[kk * 33 + (lane & 31)] = w; }
    asm volatile("s_waitcnt lgkmcnt(0)" ::: "memory");
    const int c = lane & 7;
#pragma unroll
    for (int j = 0; j < 4; ++j) { const int n = (lane >> 3) + 8 * j; const LAS float* s = scr + (8 * c) * 33 + n;
        v4u o; o.x = pk2(s[0 * 33], s[1 * 33]); o.y = pk2(s[2 * 33], s[3 * 33]); o.z = pk2(s[4 * 33], s[5 * 33]); o.w = pk2(s[6 * 33], s[7 * 33]);
        *(GAS v4u*)(WT + (size_t)(n0 + n) * K + k0 + 8 * c) = o; }
    asm volatile("s_waitcnt lgkmcnt(0)" ::: "memory");
}
__device__ __forceinline__ void rms_row_to_bf16(const float* xrow, bf16* orow, int lane) {
    const GAS f32x4* xr = (const GAS f32x4*)xrow + lane;
    f32x4 v[4]; float s = 0.f;
#pragma unroll
    for (int j = 0; j < 4; ++j) { v[j] = xr[64 * j]; s += (v[j].x * v[j].x + v[j].y * v[j].y) + (v[j].z * v[j].z + v[j].w * v[j].w); }
    const float rstd = 1.f / sqrtf(wave_sum(s) * (1.f / D) + RMS_EPS);
    GAS unsigned long long* o8 = (GAS unsigned long long*)orow + lane;
#pragma unroll
    for (int j = 0; j < 4; ++j) o8[64 * j] = (unsigned long long)pk2(v[j].x * rstd, v[j].y * rstd) | ((unsigned long long)pk2(v[j].z * rstd, v[j].w * rstd) << 32);
}
__device__ __forceinline__ void res_norm_row(const float* orow, const float* xrow, const float* g, float* x1row, bf16* xnrow, int lane) {
    const GAS f32x4* orr = (const GAS f32x4*)orow + lane; const GAS f32x4* xr = (const GAS f32x4*)xrow + lane; const GAS f32x4* gr = (const GAS f32x4*)g + lane;
    f32x4 v[4]; float s = 0.f;
#pragma unroll
    for (int j = 0; j < 4; ++j) { v[j] = orr[64 * j]; s += (v[j].x * v[j].x + v[j].y * v[j].y) + (v[j].z * v[j].z + v[j].w * v[j].w); }
    const float rstd = 1.f / sqrtf(wave_sum(s) * (1.f / D) + RMS_EPS);
    float s2 = 0.f;
#pragma unroll
    for (int j = 0; j < 4; ++j) { v[j] = xr[64 * j] + v[j] * rstd * gr[64 * j]; s2 += (v[j].x * v[j].x + v[j].y * v[j].y) + (v[j].z * v[j].z + v[j].w * v[j].w); }
    GAS f32x4* x1 = (GAS f32x4*)x1row + lane;
#pragma unroll
    for (int j = 0; j < 4; ++j) x1[64 * j] = v[j];
    if (xnrow) {
        const float rstd2 = 1.f / sqrtf(wave_sum(s2) * (1.f / D) + RMS_EPS);
        GAS unsigned long long* o8 = (GAS unsigned long long*)xnrow + lane;
#pragma unroll
        for (int j = 0; j < 4; ++j) o8[64 * j] = (unsigned long long)pk2(v[j].x * rstd2, v[j].y * rstd2) | ((unsigned long long)pk2(v[j].z * rstd2, v[j].w * rstd2) << 32);
    }
}

__device__ __forceinline__ int t5_bucket(int dist) {
    if (dist < 16) return dist;
    const int large = 16 + (int)(logf((float)dist / 16.0f) / logf(8.0f) * 16.0f);
    return large < 31 ? large : 31;
}
__device__ __forceinline__ void unpack8f(v4u w, float (&f)[8]) {
    f[0] = __uint_as_float(w.x << 16); f[1] = __uint_as_float(w.x & 0xffff0000u); f[2] = __uint_as_float(w.y << 16); f[3] = __uint_as_float(w.y & 0xffff0000u);
    f[4] = __uint_as_float(w.z << 16); f[5] = __uint_as_float(w.z & 0xffff0000u); f[6] = __uint_as_float(w.w << 16); f[7] = __uint_as_float(w.w & 0xffff0000u);
}
__device__ __forceinline__ void attn_simple_phase(const bf16* Q, const bf16* KV, bf16* ATT, const float* rel_bias, const float* sinks, int gw, int NGW, int lane) {
    const int bk0 = t5_bucket(lane), bk1 = t5_bucket(lane + 64);
    for (int unit = gw; unit < M * 8; unit += NGW) {
        const int m = unit >> 3, h = unit & 7, kvh = h >> 2, t = m & (SEQ - 1);
        const float qv = bf2f(Q[(size_t)m * 512 + h * 64 + lane]);
        const bool ok0 = (t - lane) >= 0, ok1 = (t - lane - 64) >= 0;
        const bf16* k0p = KV + (size_t)(m - (ok0 ? lane : 0)) * 256 + kvh * 64;
        const bf16* k1p = KV + (size_t)(m - (ok1 ? lane + 64 : 0)) * 256 + kvh * 64;
        float s0 = 0.f, s1 = 0.f;
#pragma unroll
        for (int d8 = 0; d8 < 8; ++d8) {
            float ka[8], kb[8]; unpack8f(*(const GAS v4u*)(k0p + d8 * 8), ka); unpack8f(*(const GAS v4u*)(k1p + d8 * 8), kb);
#pragma unroll
            for (int j = 0; j < 8; ++j) { const float qd = __shfl(qv, d8 * 8 + j); s0 += qd * ka[j]; s1 += qd * kb[j]; }
        }
        const float l0 = ok0 ? s0 + rel_bias[bk0 * 8 + h] : -1e30f, l1 = ok1 ? s1 + rel_bias[bk1 * 8 + h] : -1e30f;
        const float sink = sinks[h];
        const float mx = fmaxf(wave_max(fmaxf(l0, l1)), sink);
        float p0 = expf(l0 - mx), p1 = expf(l1 - mx);
        const float den = wave_sum(p0 + p1) + expf(sink - mx);
        p0 /= den; p1 /= den;
        float o = 0.f;
        const int nk = (t + 1) < 128 ? (t + 1) : 128;
        for (int dist = 0; dist < nk; ++dist) { const float pd = __shfl(dist < 64 ? p0 : p1, dist & 63); o += pd * bf2f(KV[(size_t)(m - dist) * 256 + 128 + kvh * 64 + lane]); }
        ATT[(size_t)m * 512 + h * 64 + lane] = (bf16)f2bf(o);
    }
}

__device__ __forceinline__ float gelu_tanh(float y) { return 0.5f * y * (1.0f + tanhf(0.7978845608028654f * (y + 0.044715f * y * y * y))); }
__device__ __forceinline__ void ssm_consts(int g, int p, const float* lam_re, const float* lam_im, const float* log_dt, const float* b_re, const float* b_im,
                                           float& abr, float& abi, float (&bbr)[16], float (&bbi)[16]) {
    const float dt = expf(log_dt[g]);
    const float lr = lam_re[g * 64 + p], li = lam_im[g * 64 + p];
    const float mag = expf(lr * dt);
    abr = mag * cosf(li * dt); abi = mag * sinf(li * dt);
    const float nr = abr - 1.0f, den = lr * lr + li * li;
    const float fr = (nr * lr + abi * li) / den, fi = (abi * lr - nr * li) / den;
#pragma unroll
    for (int c = 0; c < 16; ++c) { const float br = b_re[(size_t)(g * 64 + p) * 16 + c], bi = b_im[(size_t)(g * 64 + p) * 16 + c]; bbr[c] = fr * br - fi * bi; bbi[c] = fr * bi + fi * br; }
}
__device__ __forceinline__ void load_u16(const bf16* up, float (&uv)[16]) {
    float a[8], b[8]; unpack8f(*(const GAS v4u*)up, a); unpack8f(*(const GAS v4u*)(up + 8), b);
#pragma unroll
    for (int c = 0; c < 8; ++c) { uv[c] = a[c]; uv[8 + c] = b[c]; }
}
__device__ __forceinline__ void ssm_state_phase(const bf16* U, float* S, const float* lam_re, const float* lam_im, const float* log_dt, const float* b_re, const float* b_im, int gw, int NGW, int lane) {
    for (int unit = gw; unit < NB * NCH * 32; unit += NGW) {
        const int g = unit & 31, j = (unit >> 5) & (NCH - 1), b = unit >> 11;
        float abr, abi, bbr[16], bbi[16];
        ssm_consts(g, lane, lam_re, lam_im, log_dt, b_re, b_im, abr, abi, bbr, bbi);
        float hr = 0.f, hi = 0.f;
        const bf16* up = U + (size_t)(b * SEQ + j * TCH) * 512 + g * 16;
        for (int s = 0; s < TCH; ++s) {
            float uv[16]; load_u16(up + (size_t)s * 512, uv);
            float bur = 0.f, bui = 0.f;
#pragma unroll
            for (int c = 0; c < 16; ++c) { bur += bbr[c] * uv[c]; bui += bbi[c] * uv[c]; }
            const float nr = abr * hr - abi * hi + bur, ni = abr * hi + abi * hr + bui; hr = nr; hi = ni;
        }
        float* sp = S + ((size_t)(b * NCH + j) * 32 + g) * 128;
        sp[lane] = hr; sp[64 + lane] = hi;
    }
}
__device__ __forceinline__ void ssm_out_phase(const bf16* U, const float* S, bf16* Z, const float* lam_re, const float* lam_im, const float* log_dt, const float* b_re, const float* b_im,
                                              const float* c_re, const float* c_im, const float* d_skip, int gw, int NGW, int lane) {
    for (int unit = gw; unit < NB * NCH * 32; unit += NGW) {
        const int g = unit & 31, j = (unit >> 5) & (NCH - 1), b = unit >> 11;
        float abr, abi, bbr[16], bbi[16], cr[16], ci[16];
        ssm_consts(g, lane, lam_re, lam_im, log_dt, b_re, b_im, abr, abi, bbr, bbi);
#pragma unroll
        for (int c = 0; c < 16; ++c) { cr[c] = c_re[(size_t)(g * 16 + c) * 64 + lane]; ci[c] = c_im[(size_t)(g * 16 + c) * 64 + lane]; }
        const float dsk = d_skip[g * 16 + (lane & 15)];
        float aTr = abr, aTi = abi;
#pragma unroll
        for (int q = 0; q < 6; ++q) { const float r2 = aTr * aTr - aTi * aTi, i2 = 2.f * aTr * aTi; aTr = r2; aTi = i2; }
        float hr = 0.f, hi = 0.f;
        const float* sp = S + ((size_t)(b * NCH) * 32 + g) * 128 + lane;
        for (int m2 = 0; m2 < j; ++m2) { const float sr = sp[(size_t)m2 * 4096], si = sp[(size_t)m2 * 4096 + 64]; const float nr = aTr * hr - aTi * hi + sr, ni = aTr * hi + aTi * hr + si; hr = nr; hi = ni; }
        const bf16* up = U + (size_t)(b * SEQ + j * TCH) * 512 + g * 16;
        bf16* zp = Z + (size_t)(b * SEQ + j * TCH) * 512 + g * 16;
        for (int s = 0; s < TCH; ++s) {
            float uv[16]; load_u16(up + (size_t)s * 512, uv);
            float bur = 0.f, bui = 0.f, umine = 0.f;
#pragma unroll
            for (int c = 0; c < 16; ++c) { bur += bbr[c] * uv[c]; bui += bbi[c] * uv[c]; umine = ((lane & 15) == c) ? uv[c] : umine; }
            const float nr = abr * hr - abi * hi + bur, ni = abr * hi + abi * hr + bui; hr = nr; hi = ni;
            float ymine = 0.f;
#pragma unroll
            for (int c = 0; c < 16; ++c) { const float y = wave_sum(cr[c] * hr - ci[c] * hi); ymine = (lane == c) ? y : ymine; }
            if (lane < 16) zp[(size_t)s * 512 + lane] = (bf16)f2bf(gelu_tanh(ymine + dsk * umine));
        }
    }
}
struct Args { const float* in[22]; float* out; unsigned char* ws; };
__global__ void __launch_bounds__(NWAVES * 64, 2) mk_fwd(Args args) {
    extern __shared__ __attribute__((aligned(16))) unsigned char lds[];
    LAS unsigned char* const L3 = (LAS unsigned char*)lds;
    volatile LAS unsigned* const MISC = (volatile LAS unsigned*)(L3 + MISC_OFF);
    const int tid = threadIdx.x, lane = tid & 63, wave = __builtin_amdgcn_readfirstlane(tid >> 6);
    const int G = gridDim.x; const int bx = blockIdx.x; const int vcu = (G % 8 == 0) ? (bx % 8) * (G / 8) + bx / 8 : bx;
    const int gw = vcu * NWAVES + wave, NGW = G * NWAVES;
    unsigned char* const ws = args.ws;
    const float* x = args.in[0];
    const float *g_pre = args.in[1], *g_post = args.in[2], *g_mpre = args.in[3], *g_mpost = args.in[4];
    const float *w_in = args.in[5], *rel_bias = args.in[6], *sinks = args.in[7];
    const float *lam_re = args.in[8], *lam_im = args.in[9], *log_dt = args.in[10], *b_re = args.in[11], *b_im = args.in[12], *c_re = args.in[13], *c_im = args.in[14], *d_skip = args.in[15];
    const float *w_glu = args.in[16], *w_ab = args.in[17], *w_sb = args.in[18], *w_out = args.in[19], *w_ff1 = args.in[20], *w_ff2 = args.in[21];
    float* const out = args.out;
    bf16 *Win_t = (bf16*)(ws + WS_WIN), *Wglu_t = (bf16*)(ws + WS_WGLU), *Wab_t = (bf16*)(ws + WS_WAB), *Wsb_t = (bf16*)(ws + WS_WSB), *Wout_t = (bf16*)(ws + WS_WOUT), *Wff1_t = (bf16*)(ws + WS_WFF1), *Wff2_t = (bf16*)(ws + WS_WFF2);
    bf16 *XN = (bf16*)(ws + WS_XN), *Qb = (bf16*)(ws + WS_Q), *KVb = (bf16*)(ws + WS_KV), *Ub = (bf16*)(ws + WS_U), *GA = (bf16*)(ws + WS_GA), *GS = (bf16*)(ws + WS_GS);
    bf16 *ATT = (bf16*)(ws + WS_ATT), *Zb = (bf16*)(ws + WS_Z), *Z2 = (bf16*)(ws + WS_Z2), *YA = (bf16*)(ws + WS_YA), *MG = (bf16*)(ws + WS_MG), *F1 = (bf16*)(ws + WS_F1);
    float *Sst = (float*)(ws + WS_S), *Ob = (float*)(ws + WS_O), *F2 = (float*)(ws + WS_F2);

    for (int u = tid; u < (LDS_BYTES - LDSCTL_OFF) / 4; u += NWAVES * 64) ((LAS unsigned*)(L3 + LDSCTL_OFF))[u] = 0u;
    __syncthreads();
    const XcdBarrier bar = xcd_barrier_post((unsigned*)(ws + WS_CTL) + CW_BAR, MISC + 8);

    {
        LAS float* scr = (LAS float*)(L3 + wave * 16384);
        constexpr int I_IN = (D / 64) * (INW / 32), I_GLU = (512 / 64) * (512 / 32), I_AB = (512 / 64) * (D / 32), I_SB = I_AB, I_OUT = (D / 64) * (D / 32), I_F1 = (D / 64) * (DFF / 32), I_F2 = (DFF / 64) * (D / 32);
        constexpr int NITEMS = I_IN + I_GLU + I_AB + I_SB + I_OUT + I_F1 + I_F2;
        for (int it = gw; it < NITEMS; it += NGW) {
            int r = it;
            if (r < I_IN) { p0_transpose_item(w_in, g_pre, D, INW, Win_t, scr, r, lane); continue; } r -= I_IN;
            if (r < I_GLU) { p0_transpose_item(w_glu, nullptr, 512, 512, Wglu_t, scr, r, lane); continue; } r -= I_GLU;
            if (r < I_AB) { p0_transpose_item(w_ab, nullptr, 512, D, Wab_t, scr, r, lane); continue; } r -= I_AB;
            if (r < I_SB) { p0_transpose_item(w_sb, nullptr, 512, D, Wsb_t, scr, r, lane); continue; } r -= I_SB;
            if (r < I_OUT) { p0_transpose_item(w_out, nullptr, D, D, Wout_t, scr, r, lane); continue; } r -= I_OUT;
            if (r < I_F1) { p0_transpose_item(w_ff1, g_mpre, D, DFF, Wff1_t, scr, r, lane); continue; } r -= I_F1;
            p0_transpose_item(w_ff2, nullptr, DFF, D, Wff2_t, scr, r, lane);
        }
        for (int m = gw; m < M; m += NGW) rms_row_to_bf16(x + (size_t)m * D, XN + (size_t)m * D, lane);
    }
    xcd_barrier(bar);

    {
        pg8::Gemm g{XN, Win_t, M, INW, D}; pg8::StaticOrder S; S.init(M, INW, G, bx);
        pg8::EpiProj E{Qb, KVb, Ub, GA, GS};
        pg8::gemm_phase<pg8::EpiProj, pg8::StaticOrder, true, true>(L3, g, S, E);
    }
    xcd_barrier(bar);

    attn_simple_phase(Qb, KVb, ATT, rel_bias, sinks, gw, NGW, lane);
    ssm_state_phase(Ub, Sst, lam_re, lam_im, log_dt, b_re, b_im, gw, NGW, lane);
    xcd_barrier(bar);

    ssm_out_phase(Ub, Sst, Zb, lam_re, lam_im, log_dt, b_re, b_im, c_re, c_im, d_skip, gw, NGW, lane);
    xcd_barrier(bar);

    {
        pg8::Gemm g{Zb, Wglu_t, M, 512, 512}; pg8::StaticOrder S; S.init(M, 512, G, bx);
        pg8::EpiGlu E{Zb, Z2};
        pg8::gemm_phase<pg8::EpiGlu, pg8::StaticOrder, true, true>(L3, g, S, E);
    }
    {
        pg8::Gemm g{ATT, Wab_t, M, D, 512}; pg8::StaticOrder S; S.init(M, D, G, bx);
        pg8::EpiGate E{GA, nullptr, YA};
        pg8::gemm_phase<pg8::EpiGate, pg8::StaticOrder, true, true>(L3, g, S, E);
    }
    xcd_barrier(bar);

    {
        pg8::Gemm g{Z2, Wsb_t, M, D, 512}; pg8::StaticOrder S; S.init(M, D, G, bx);
        pg8::EpiGate E{GS, YA, MG};
        pg8::gemm_phase<pg8::EpiGate, pg8::StaticOrder, true, true>(L3, g, S, E);
    }
    xcd_barrier(bar);

    {
        pg8::Gemm g{MG, Wout_t, M, D, D}; pg8::StaticOrder S; S.init(M, D, G, bx);
        pg8::EpiF32 E{Ob, D};
        pg8::gemm_phase<pg8::EpiF32, pg8::StaticOrder, true, true>(L3, g, S, E);
    }
    xcd_barrier(bar);
    for (int m = gw; m < M; m += NGW) res_norm_row(Ob + (size_t)m * D, x + (size_t)m * D, g_post, out + (size_t)m * D, XN + (size_t)m * D, lane);
    xcd_barrier(bar);

    {
        pg8::Gemm g{XN, Wff1_t, M, DFF, D}; pg8::StaticOrder S; S.init(M, DFF, G, bx);
        pg8::EpiRelu2 E{F1, DFF};
        pg8::gemm_phase<pg8::EpiRelu2, pg8::StaticOrder, true, true>(L3, g, S, E);
    }
    xcd_barrier(bar);

    {
        pg8::Gemm g{F1, Wff2_t, M, D, DFF}; pg8::StaticOrder S; S.init(M, D, G, bx);
        pg8::EpiF32 E{F2, D};
        pg8::gemm_phase<pg8::EpiF32, pg8::StaticOrder, true, true>(L3, g, S, E);
    }
    xcd_barrier(bar);
    for (int m = gw; m < M; m += NGW) res_norm_row(F2 + (size_t)m * D, out + (size_t)m * D, g_mpost, out + (size_t)m * D, nullptr, lane);
}

extern "C" void kernel_launch(void* const* d_in, const int* in_sizes, int n_in, void* d_out, int out_size, void* d_ws, size_t ws_size, hipStream_t stream) {
    static int grid = 0;
    if (grid == 0) {
        if (n_in != 22 || in_sizes[0] != M * D || out_size != M * D || ws_size < WS_END) { fprintf(stderr, "kernel_launch: unexpected shapes (n_in %d, in0 %d, out %d, ws %zu)\n", n_in, n_in > 0 ? in_sizes[0] : -1, out_size, ws_size); grid = -1; return; }
        int dev = 0, cus = 0, per_cu = 0;
        if (hipGetDevice(&dev) != hipSuccess || hipDeviceGetAttribute(&cus, hipDeviceAttributeMultiprocessorCount, dev) != hipSuccess) { grid = -1; return; }
        if (hipFuncSetAttribute((const void*)mk_fwd, hipFuncAttributeMaxDynamicSharedMemorySize, LDS_BYTES) != hipSuccess) { fprintf(stderr, "kernel_launch: hipFuncSetAttribute failed\n"); grid = -1; return; }
        if (hipOccupancyMaxActiveBlocksPerMultiprocessor(&per_cu, (const void*)mk_fwd, NWAVES * 64, LDS_BYTES) != hipSuccess || per_cu < 1) fprintf(stderr, "kernel_launch: occupancy query reports %d workgroups per CU\n", per_cu);
        (void)hipGetLastError();
        grid = cus;
    }
    if (grid < 0) return;
    if (hipMemsetAsync((char*)d_ws + WS_CTL, 0, CTL_ZERO_BYTES, stream) != hipSuccess) { fprintf(stderr, "kernel_launch: memset failed\n"); return; }
    Args a{};
    for (int i = 0; i < 22; ++i) a.in[i] = (const float*)d_in[i];
    a.out = (float*)d_out; a.ws = (unsigned char*)d_ws;
    hipLaunchKernelGGL(mk_fwd, dim3(grid), dim3(NWAVES * 64), LDS_BYTES, stream, a);
    const hipError_t le = hipPeekAtLastError();
    if (le != hipSuccess) fprintf(stderr, "kernel_launch: launch failed: %s\n", hipGetErrorName(le));
}
```

```cpp
#include <hip/hip_runtime.h>
#include <cstdio>
#include <cstdint>
#include <cmath>
namespace pg8 {
#define PG8_LAS __attribute__((address_space(3)))
typedef unsigned short bf16_t;
typedef short bf16x8 __attribute__((ext_vector_type(8)));
typedef float f32x4 __attribute__((ext_vector_type(4)));
typedef unsigned u32x4 __attribute__((ext_vector_type(4)));
constexpr int BM = 256, BK = 64, HALF = 128, HTB = HALF * BK * 2  , STAGE_BYTES = 8 * HTB, NXCD = 8, WGM = 8;

__host__ __device__ __forceinline__ int lds_byte(int r, int c) { const int st = (r >> 4) * 2 + (c >> 5), rr = r & 15, cc = c & 31, ob = rr * 64 + cc * 2; return st * 1024 + (ob ^ (((ob >> 9) & 1) << 5)); }
__host__ __device__ __forceinline__ void stage_rc(int b, int& R, int& C) { const int st = b / 1024, sb = b % 1024, swz = sb ^ (((sb >> 9) & 1) << 5); R = (st >> 1) * 16 + swz / 64; C = (st & 1) * 32 + (swz % 64) / 2; }
__host__ __device__ __forceinline__ int perm32(int rho) { const int n = rho >> 4, i = rho & 15; return 8 * (i >> 2) + 4 * n + (i & 3); }

struct Unit { int pm, pn; };
struct Gemm { const bf16_t* A; const bf16_t* Bt; int M, N, K; };

struct StaticOrder {
    int nM, nN, nwg, G, c;
    __host__ __device__ void init(int M, int N, int G_, int c_) { nM = M / BM; nN = N / BM; nwg = nM * nN; G = G_; c = c_; }
    __host__ __device__ bool next(int i, Unit& u) const {
        const long L = (long)i * G + c; if (L >= nwg) return false;
        int wgid = (int)L; { const int q = nwg / NXCD, r = nwg % NXCD, xcd = wgid % NXCD, off = wgid / NXCD; wgid = (xcd < r ? xcd * (q + 1) : r * (q + 1) + (xcd - r) * q) + off; }
        const int nig = WGM * nN, gid = wgid / nig, fm = gid * WGM, gsz = (nM - fm) < WGM ? (nM - fm) : WGM;
        u.pm = fm + ((wgid % nig) % gsz); u.pn = (wgid % nig) / gsz; return true;
    }
    __device__ __forceinline__ void a_ready(const Unit&) const {}
    __device__ __forceinline__ void done(const Unit&) const {}
};
__device__ __forceinline__ unsigned cvt_pk_bf16(float lo, float hi) { unsigned r; asm volatile("v_cvt_pk_bf16_f32 %0, %1, %2" : "=v"(r) : "v"(lo), "v"(hi)); return r; }
typedef float f32x2 __attribute__((ext_vector_type(2)));
__device__ __forceinline__ float bf_lo(unsigned w) { return __uint_as_float(w << 16); }
__device__ __forceinline__ float bf_hi(unsigned w) { return __uint_as_float(w & 0xffff0000u); }
__device__ __forceinline__ float fast_sigmoid(float x) { return __builtin_amdgcn_rcpf(1.0f + __builtin_amdgcn_exp2f(-1.4426950408889634f * x)); }
__device__ __forceinline__ u32x4 pack8(f32x4 v0, f32x4 v1) { u32x4 w; w.x = cvt_pk_bf16(v0[0], v0[1]); w.y = cvt_pk_bf16(v0[2], v0[3]); w.z = cvt_pk_bf16(v1[0], v1[1]); w.w = cvt_pk_bf16(v1[2], v1[3]); return w; }
__device__ __forceinline__ void unpack8(u32x4 w, f32x4& v0, f32x4& v1) { v0 = (f32x4){bf_lo(w.x), bf_hi(w.x), bf_lo(w.y), bf_hi(w.y)}; v1 = (f32x4){bf_lo(w.z), bf_hi(w.z), bf_lo(w.w), bf_hi(w.w)}; }
__device__ __forceinline__ f32x4 sig4(f32x4 v) { return (f32x4){fast_sigmoid(v[0]), fast_sigmoid(v[1]), fast_sigmoid(v[2]), fast_sigmoid(v[3])}; }

struct EpiProj {
    static constexpr bool PERM = true, AFTER_DRAIN = false;
    bf16_t *Q, *KV, *U, *GA, *GS;
    __device__ __forceinline__ void operator()(const f32x4 (&acc)[2][2][4][2], const Unit& u, int wr, int wc, int fr, int fq) const {
        const int pn = u.pn; bf16_t* base; int ldc, colt, mode;
        if (pn < 2) { base = Q; ldc = 512; colt = pn * 256; mode = 1; }
        else if (pn == 2) { base = KV; ldc = 256; colt = 0; mode = 0; }
        else if (pn < 5) { base = U; ldc = 512; colt = (pn - 3) * 256; mode = 0; }
        else if (pn < 9) { base = GA; ldc = 1024; colt = (pn - 5) * 256; mode = 2; }
        else { base = GS; ldc = 1024; colt = (pn - 9) * 256; mode = 2; }
        const int row0 = u.pm * BM + wr * 64 + fr, col0 = colt + wc * 32 + 8 * fq;
#pragma unroll
        for (int ai = 0; ai < 2; ++ai)
#pragma unroll
            for (int m = 0; m < 4; ++m) { bf16_t* rowp = base + (size_t)(row0 + ai * HALF + m * 16) * ldc + col0;
#pragma unroll
                for (int bj = 0; bj < 2; ++bj) { f32x4 v0 = acc[ai][bj][m][0], v1 = acc[ai][bj][m][1];
                    if (mode == 1) { v0 = v0 * 0.18033688011112042f; v1 = v1 * 0.18033688011112042f; }
                    if (mode == 2) { v0 = sig4(v0); v1 = sig4(v1); }
                    *(u32x4*)(rowp + bj * HALF) = pack8(v0, v1); } }
    }
};
struct EpiGlu {
    static constexpr bool PERM = true, AFTER_DRAIN = false;
    const bf16_t* Z; bf16_t* Z2;
    __device__ __forceinline__ void operator()(const f32x4 (&acc)[2][2][4][2], const Unit& u, int wr, int wc, int fr, int fq) const {
        const int row0 = u.pm * BM + wr * 64 + fr, col0 = u.pn * BM + wc * 32 + 8 * fq;
#pragma unroll
        for (int ai = 0; ai < 2; ++ai)
#pragma unroll
            for (int m = 0; m < 4; ++m) { const size_t off = (size_t)(row0 + ai * HALF + m * 16) * 512 + col0;
#pragma unroll
                for (int bj = 0; bj < 2; ++bj) { f32x4 z0, z1; unpack8(*(const u32x4*)(Z + off + bj * HALF), z0, z1);
                    *(u32x4*)(Z2 + off + bj * HALF) = pack8(z0 * sig4(acc[ai][bj][m][0]), z1 * sig4(acc[ai][bj][m][1])); } }
    }
};
struct EpiGate {
    static constexpr bool PERM = true, AFTER_DRAIN = false;
    const bf16_t* gate; const bf16_t* addend; bf16_t* O;
    __device__ __forceinline__ void operator()(const f32x4 (&acc)[2][2][4][2], const Unit& u, int wr, int wc, int fr, int fq) const {
        const int row0 = u.pm * BM + wr * 64 + fr, col0 = u.pn * BM + wc * 32 + 8 * fq;
#pragma unroll
        for (int ai = 0; ai < 2; ++ai)
#pragma unroll
            for (int m = 0; m < 4; ++m) { const size_t off = (size_t)(row0 + ai * HALF + m * 16) * 1024 + col0;
#pragma unroll
                for (int bj = 0; bj < 2; ++bj) { f32x4 g0, g1; unpack8(*(const u32x4*)(gate + off + bj * HALF), g0, g1);
                    f32x4 v0 = g0 * acc[ai][bj][m][0], v1 = g1 * acc[ai][bj][m][1];
                    if (addend) { f32x4 a0, a1; unpack8(*(const u32x4*)(addend + off + bj * HALF), a0, a1); v0 = v0 + a0; v1 = v1 + a1; }
                    *(u32x4*)(O + off + bj * HALF) = pack8(v0, v1); } }
    }
};
struct EpiF32 {
    static constexpr bool PERM = false, AFTER_DRAIN = false;
    float* C; int ldc;
    __device__ __forceinline__ void operator()(const f32x4 (&acc)[2][2][4][2], const Unit& u, int wr, int wc, int fr, int fq) const {
        const int row0 = u.pm * BM + wr * 64 + fr, col0 = u.pn * BM + wc * 32 + 4 * fq;
#pragma unroll
        for (int ai = 0; ai < 2; ++ai)
#pragma unroll
            for (int m = 0; m < 4; ++m) { float* rowp = C + (size_t)(row0 + ai * HALF + m * 16) * ldc + col0;
#pragma unroll
                for (int bj = 0; bj < 2; ++bj)
#pragma unroll
                    for (int n = 0; n < 2; ++n) *(f32x4*)(rowp + bj * HALF + n * 16) = acc[ai][bj][m][n]; }
    }
};
struct EpiRelu2 {
    static constexpr bool PERM = true, AFTER_DRAIN = false;
    bf16_t* O; int ldc;
    __device__ __forceinline__ void operator()(const f32x4 (&acc)[2][2][4][2], const Unit& u, int wr, int wc, int fr, int fq) const {
        const int row0 = u.pm * BM + wr * 64 + fr, col0 = u.pn * BM + wc * 32 + 8 * fq;
#pragma unroll
        for (int ai = 0; ai < 2; ++ai)
#pragma unroll
            for (int m = 0; m < 4; ++m) { bf16_t* rowp = O + (size_t)(row0 + ai * HALF + m * 16) * ldc + col0;
#pragma unroll
                for (int bj = 0; bj < 2; ++bj) { f32x4 v0 = acc[ai][bj][m][0], v1 = acc[ai][bj][m][1];
#pragma unroll
                    for (int j = 0; j < 4; ++j) { const float a = fmaxf(v0[j], 0.f), b = fmaxf(v1[j], 0.f); v0[j] = a * a; v1[j] = b * b; }
                    *(u32x4*)(rowp + bj * HALF) = pack8(v0, v1); } }
    }
};

template <class Epi, class Sched, bool ALIGN_EPI = false, bool SP2 = false>
__device__ __forceinline__ void gemm_phase(PG8_LAS unsigned char* lds, const Gemm g, const Sched& S, const Epi& E) {
    const int tid = threadIdx.x, wid = __builtin_amdgcn_readfirstlane(tid >> 6), lane = tid & 63, wr = wid >> 2, wc = wid & 3, fr = lane & 15, fq = lane >> 4;
    const int K = g.K, nt = K / BK;
    unsigned voffA[2], voffB[2];
#pragma unroll
    for (int i = 0; i < 2; ++i) { int R, C; stage_rc(tid * 16 + i * 8192, R, C); const int Rb = Epi::PERM ? ((R & ~31) + perm32(R & 31)) : R;
        voffA[i] = (unsigned)(R * K + C) * 2u; voffB[i] = (unsigned)(Rb * K + C) * 2u; }
    const size_t kstep = (size_t)(BK * 2);
    const size_t hstep = (size_t)HALF * K * 2;
    const size_t tstep = 2 * hstep;
    const unsigned ldsw = (unsigned)wid * 1024u;
    const int aoff = lds_byte(wr * 64 + fr, fq * 8), boff = lds_byte(wc * 32 + fr, fq * 8);
#define PG8_SA(b, h) (((b) * 2 + (h)) * HTB)
#define PG8_SB(b, h) ((4 + (b) * 2 + (h)) * HTB)
#define PG8_STAGE(bufoff, gbase, voff) do { _Pragma("unroll") for (int _i = 0; _i < 2; ++_i) \
        __builtin_amdgcn_global_load_lds((const unsigned*)((const char*)(gbase) + (voff)[_i]), (PG8_LAS unsigned*)(lds + (bufoff) + ldsw + _i * 8192), 16, 0, 0); } while (0)
#define PG8_LDA(dst, b, h) do { _Pragma("unroll") for (int m = 0; m < 4; ++m) _Pragma("unroll") for (int k = 0; k < 2; ++k) dst[m][k] = *(const PG8_LAS bf16x8*)(lds + PG8_SA(b, h) + aoff + m * 2048 + k * 1024); } while (0)
#define PG8_LDB(dst, b, h) do { _Pragma("unroll") for (int n = 0; n < 2; ++n) _Pragma("unroll") for (int k = 0; k < 2; ++k) dst[n][k] = *(const PG8_LAS bf16x8*)(lds + PG8_SB(b, h) + boff + n * 2048 + k * 1024); } while (0)
#define PG8_MMA(ai, bj, At, Bt) do { __builtin_amdgcn_s_setprio(1); _Pragma("unroll") for (int m = 0; m < 4; ++m) _Pragma("unroll") for (int n = 0; n < 2; ++n) _Pragma("unroll") for (int k = 0; k < 2; ++k) \
        acc[ai][bj][m][n] = __builtin_amdgcn_mfma_f32_16x16x32_bf16(Bt[n][k], At[m][k], acc[ai][bj][m][n], 0, 0, 0); __builtin_amdgcn_s_setprio(0); } while (0)
#define PG8_WAIT_V(n) asm volatile("s_waitcnt vmcnt(" #n ")" ::: "memory")
#define PG8_WAIT_L(n) asm volatile("s_waitcnt lgkmcnt(" #n ")" ::: "memory")
#define PG8_BAR __builtin_amdgcn_s_barrier()
#define PG8_SCHED __builtin_amdgcn_sched_barrier(0)
    Unit cur, nxt; int ui = 0;
    if (!S.next(0, cur)) return;
    f32x4 acc[2][2][4][2];
#pragma unroll
    for (int a = 0; a < 2; ++a)
#pragma unroll
        for (int b = 0; b < 2; ++b)
#pragma unroll
            for (int m = 0; m < 4; ++m)
#pragma unroll
                for (int n = 0; n < 2; ++n) acc[a][b][m][n] = (f32x4){0.f, 0.f, 0.f, 0.f};
    bf16x8 At[4][2], B0[2][2], B1[2][2];
    const char* cA = (const char*)g.A + (size_t)cur.pm * tstep; const char* cB = (const char*)g.Bt + (size_t)cur.pn * tstep;
    S.a_ready(cur);
    if constexpr (SP2) {
        PG8_STAGE(PG8_SB(0, 0), cB, voffB); PG8_STAGE(PG8_SB(0, 1), cB + hstep, voffB); PG8_STAGE(PG8_SA(0, 0), cA, voffA); PG8_STAGE(PG8_SA(0, 1), cA + hstep, voffA);
        if (wr == 1) PG8_BAR;
        PG8_WAIT_V(2); PG8_BAR;
        PG8_STAGE(PG8_SB(1, 0), cB + kstep, voffB); PG8_STAGE(PG8_SA(1, 0), cA + kstep, voffA); PG8_STAGE(PG8_SB(1, 1), cB + hstep + kstep, voffB);
        PG8_WAIT_V(6); PG8_BAR;
    } else {
        PG8_STAGE(PG8_SB(0, 0), cB, voffB); PG8_STAGE(PG8_SA(0, 0), cA, voffA); PG8_STAGE(PG8_SB(0, 1), cB + hstep, voffB); PG8_STAGE(PG8_SA(0, 1), cA + hstep, voffA);
        if (wr == 1) PG8_BAR;
        PG8_WAIT_V(4); PG8_BAR;
        PG8_STAGE(PG8_SB(1, 0), cB + kstep, voffB); PG8_STAGE(PG8_SA(1, 0), cA + kstep, voffA); PG8_STAGE(PG8_SB(1, 1), cB + hstep + kstep, voffB);
        PG8_WAIT_V(6); PG8_BAR;
    }
    for (;;) {
        const bool has_next = S.next(ui + 1, nxt);
        const char* nA = has_next ? (const char*)g.A + (size_t)nxt.pm * tstep : cA; const char* nB = has_next ? (const char*)g.Bt + (size_t)nxt.pn * tstep : cB;
        for (int t = 0; t < nt; t += 2) {
            const bool last = (t == nt - 2);
            const char* a1 = cA + (size_t)(t + 1) * kstep;
            const char* a2 = last ? nA : cA + (size_t)(t + 2) * kstep; const char* b2 = last ? nB : cB + (size_t)(t + 2) * kstep;
            const char* a3 = a2 + kstep; const char* b3 = b2 + kstep;
            if (last && has_next) S.a_ready(nxt);
            if constexpr (SP2) {
            PG8_LDB(B0, 0, 0); PG8_LDB(B1, 0, 1); PG8_SCHED; PG8_LDA(At, 0, 0); PG8_STAGE(PG8_SA(1, 1), a1 + hstep, voffA);
            PG8_WAIT_V(8); PG8_WAIT_L(0); PG8_BAR; PG8_MMA(0, 0, At, B0); PG8_MMA(0, 1, At, B1); PG8_BAR; PG8_SCHED;
            PG8_LDA(At, 0, 1); PG8_STAGE(PG8_SB(0, 0), b2, voffB); PG8_STAGE(PG8_SB(0, 1), b2 + hstep, voffB); PG8_STAGE(PG8_SA(0, 0), a2, voffA);
            PG8_WAIT_V(8); PG8_WAIT_L(0); PG8_BAR; PG8_MMA(1, 0, At, B0); PG8_MMA(1, 1, At, B1); PG8_BAR; PG8_SCHED;
            PG8_LDB(B0, 1, 0); PG8_LDB(B1, 1, 1); PG8_SCHED; PG8_LDA(At, 1, 0); PG8_STAGE(PG8_SA(0, 1), a2 + hstep, voffA);
            PG8_WAIT_V(8); PG8_WAIT_L(0); PG8_BAR; PG8_MMA(0, 0, At, B0); PG8_MMA(0, 1, At, B1); PG8_BAR; PG8_SCHED;
            PG8_LDA(At, 1, 1); PG8_STAGE(PG8_SB(1, 0), b3, voffB); PG8_STAGE(PG8_SB(1, 1), b3 + hstep, voffB); PG8_STAGE(PG8_SA(1, 0), a3, voffA);
            PG8_WAIT_V(8); PG8_WAIT_L(0); PG8_BAR; PG8_MMA(1, 0, At, B0); PG8_MMA(1, 1, At, B1); PG8_BAR; PG8_SCHED;
            } else {
            PG8_LDB(B0, 0, 0); PG8_SCHED; PG8_LDA(At, 0, 0); PG8_STAGE(PG8_SA(1, 1), a1 + hstep, voffA);
            PG8_WAIT_L(8); PG8_BAR; PG8_WAIT_L(0); PG8_MMA(0, 0, At, B0); PG8_BAR; PG8_SCHED;
            PG8_LDB(B1, 0, 1); PG8_STAGE(PG8_SB(0, 0), b2, voffB);
            PG8_BAR; PG8_WAIT_L(0); PG8_MMA(0, 1, At, B1); PG8_BAR;
            PG8_LDA(At, 0, 1); PG8_STAGE(PG8_SA(0, 0), a2, voffA);
            PG8_BAR; PG8_WAIT_L(0); PG8_MMA(1, 0, At, B0); PG8_BAR; PG8_SCHED;
            PG8_STAGE(PG8_SB(0, 1), b2 + hstep, voffB);
            PG8_WAIT_V(6); PG8_BAR; PG8_MMA(1, 1, At, B1); PG8_BAR;
            PG8_LDB(B0, 1, 0); PG8_SCHED; PG8_LDA(At, 1, 0); PG8_STAGE(PG8_SA(0, 1), a2 + hstep, voffA);
            PG8_WAIT_L(8); PG8_BAR; PG8_WAIT_L(0); PG8_MMA(0, 0, At, B0); PG8_BAR; PG8_SCHED;
            PG8_LDB(B1, 1, 1); PG8_STAGE(PG8_SB(1, 0), b3, voffB);
            PG8_BAR; PG8_WAIT_L(0); PG8_MMA(0, 1, At, B1); PG8_BAR;
            PG8_LDA(At, 1, 1); PG8_STAGE(PG8_SA(1, 0), a3, voffA);
            PG8_BAR; PG8_WAIT_L(0); PG8_MMA(1, 0, At, B0); PG8_BAR; PG8_SCHED;
            PG8_STAGE(PG8_SB(1, 1), b3 + hstep, voffB);
            PG8_WAIT_V(6); PG8_BAR; PG8_MMA(1, 1, At, B1); PG8_BAR;
            }
        }
        if constexpr (ALIGN_EPI) { if (wr == 0) PG8_BAR; }
        if constexpr (!Epi::AFTER_DRAIN) { E(acc, cur, wr, wc, fr, fq); S.done(cur); }
        if (!has_next) break;
#pragma unroll
        for (int a = 0; a < 2; ++a)
#pragma unroll
            for (int b = 0; b < 2; ++b)
#pragma unroll
                for (int m = 0; m < 4; ++m)
#pragma unroll
                    for (int n = 0; n < 2; ++n) acc[a][b][m][n] = (f32x4){0.f, 0.f, 0.f, 0.f};
        cur = nxt; cA = nA; cB = nB; ++ui;
        if constexpr (ALIGN_EPI) { if (wr == 1) PG8_BAR; }
    }
    PG8_WAIT_V(0);
    if constexpr (!ALIGN_EPI) { if (wr == 0) PG8_BAR; }
    PG8_BAR;
    if constexpr (Epi::AFTER_DRAIN) { E.fused(acc, cur, wr, wc, fr, fq, lds, wid, lane); S.done(cur); }
#undef PG8_SA
#undef PG8_SB
#undef PG8_STAGE
#undef PG8_LDA
#undef PG8_LDB
#undef PG8_MMA
#undef PG8_WAIT_V
#undef PG8_WAIT_L
#undef PG8_BAR
#undef PG8_SCHED
}
}
constexpr int NWAVES = 8;
constexpr int NB = 4, SEQ = 4096, M = NB * SEQ, D = 1024, INW = 3328, DFF = 4096;
constexpr int TCH = 64, NCH = SEQ / TCH;
constexpr float RMS_EPS = 1e-6f;
constexpr size_t MiB = 1u << 20;
constexpr size_t WS_CTL = 0, CTL_ZERO_BYTES = 64 * 1024;
constexpr size_t WS_WIN = 1 * MiB, WS_WGLU = 8 * MiB, WS_WAB = 9 * MiB, WS_WSB = 10 * MiB, WS_WOUT = 11 * MiB, WS_WFF1 = 13 * MiB, WS_WFF2 = 21 * MiB;
constexpr size_t WS_XN = 30 * MiB;
constexpr size_t WS_Q = 62 * MiB, WS_KV = 78 * MiB, WS_U = 86 * MiB, WS_GA = 102 * MiB, WS_GS = 134 * MiB, WS_ATT = 166 * MiB, WS_Z = 182 * MiB, WS_Z2 = 198 * MiB, WS_YA = 214 * MiB;
constexpr size_t WS_S = 246 * MiB;
constexpr size_t WS_KTAB = 250 * MiB, WS_PWR = 251 * MiB, WS_PWI = 252 * MiB, WS_BBR = 253 * MiB, WS_BBI = 253 * MiB + 512 * 1024;
constexpr size_t WS_MG = 62 * MiB;
constexpr size_t WS_O = 102 * MiB;
constexpr size_t WS_F1 = 62 * MiB;
constexpr size_t WS_F2 = 190 * MiB;
constexpr size_t WS_END = 254 * MiB;
constexpr int CW_BAR = 4096;
constexpr int RING_BYTES = 131072, LDSCTL_OFF = RING_BYTES, MISC_OFF = LDSCTL_OFF + 320, LDS_BYTES = 147456;

#define GAS __attribute__((address_space(1)))
#define LAS __attribute__((address_space(3)))
typedef unsigned short bf16;
typedef unsigned v4u __attribute__((ext_vector_type(4)));
typedef float f32x4 __attribute__((ext_vector_type(4)));
__device__ __forceinline__ unsigned f2bf(float f) { unsigned u = __builtin_bit_cast(unsigned, f); return (u + 0x7fffu + ((u >> 16) & 1u)) >> 16; }
__device__ __forceinline__ unsigned pk2(float lo, float hi) { return f2bf(lo) | (f2bf(hi) << 16); }
__device__ __forceinline__ float bf2f(bf16 v) { return __uint_as_float((unsigned)v << 16); }
__device__ __forceinline__ float wave_sum(float v) {
#pragma unroll
    for (int o = 1; o < 64; o <<= 1) v += __shfl_xor(v, o);
    return v;
}
__device__ __forceinline__ float wave_max(float v) {
#pragma unroll
    for (int o = 1; o < 64; o <<= 1) v = fmaxf(v, __shfl_xor(v, o));
    return v;
}
#define XB_TMO      128
#define XB_XCNT(j)  (256  + 64 * (j))
#define XB_XSUB(j)  (1280 + 64 * (j))
#define XB_XGEN(j)  (2304 + 64 * (j))
#define XB_TOP      3328
#define XB_TOPGEN   3392
#define XCD_BAR_WORDS 3456
#define XB_SPIN_CAP (1u << 18)

__device__ __forceinline__ unsigned xb_ld(unsigned* p)              { return __hip_atomic_load(p, __ATOMIC_RELAXED, __HIP_MEMORY_SCOPE_AGENT); }
__device__ __forceinline__ unsigned xb_add(unsigned* p, unsigned v) { return __hip_atomic_fetch_add(p, v, __ATOMIC_RELAXED, __HIP_MEMORY_SCOPE_AGENT); }
__device__ __forceinline__ unsigned xb_xcc_id() { return (unsigned)__builtin_amdgcn_s_getreg((3 << 11) | 20) & 0xFu; }
#define XB_SPIN(cond, bar) do { unsigned _sp = 0; while (cond) { __builtin_amdgcn_s_sleep(1); \
    if ((++_sp & 255u) == 0u) { if (xb_ld(&(bar)[XB_TMO])) break; if (_sp > XB_SPIN_CAP) { atomicAdd(&(bar)[XB_TMO], 1u); break; } } } } while (0)

struct XcdBarrier {
    unsigned* bar; unsigned x;
    volatile LAS unsigned* st;
};

__device__ __forceinline__ XcdBarrier xcd_barrier_post(unsigned* bar, volatile LAS unsigned* st) {
    XcdBarrier b; b.bar = bar; b.x = xb_xcc_id(); b.st = st;
    if (threadIdx.x == 0) (void)xb_add(&bar[XB_XCNT(b.x)], 1u);
    return b;
}
__device__ __forceinline__ void xcd_barrier_complete(unsigned* bar, unsigned x, unsigned& nloc, unsigned& nx) {
    const unsigned G = gridDim.x * gridDim.y * gridDim.z;
    unsigned sum, cnt, mine, sp = 0u;
    for (;;) {
        sum = 0u; cnt = 0u; mine = 0u;
#pragma unroll
        for (unsigned j = 0; j < 16; ++j) { const unsigned c = xb_ld(&bar[XB_XCNT(j)]); sum += c; cnt += (c > 0u) ? 1u : 0u; mine = (j == x) ? c : mine; }
        if (sum == G) break;
        __builtin_amdgcn_s_sleep(1);
        if ((++sp & 255u) == 0u) { if (xb_ld(&bar[XB_TMO])) break; if (sp > XB_SPIN_CAP) { atomicAdd(&bar[XB_TMO], 1u); break; } }
    }
    nloc = mine > 0u ? mine : 1u; nx = cnt > 0u ? cnt : 1u;
}

__device__ __forceinline__ void xcd_barrier(const XcdBarrier& b) {
    asm volatile("s_waitcnt vmcnt(0)" ::: "memory");
    __syncthreads();
    if (threadIdx.x == 0) {
        unsigned* bar = b.bar;
        __builtin_amdgcn_s_waitcnt(0);
        unsigned nloc = b.st[0], nx = b.st[1];
        if (nloc == 0u) { xcd_barrier_complete(bar, b.x, nloc, nx); b.st[0] = nloc; b.st[1] = nx; }
        const unsigned old = xb_add(&bar[XB_XSUB(b.x)], 1u);
        const unsigned gen = old / nloc;
        if (old + 1u == (gen + 1u) * nloc) {
            __builtin_amdgcn_fence(__ATOMIC_RELEASE, "agent");
            asm volatile("s_waitcnt vmcnt(0)" ::: "memory");
            const unsigned og = xb_add(&bar[XB_TOP], 1u);
            const unsigned tg = og / nx;
            if (og + 1u == (tg + 1u) * nx) xb_add(&bar[XB_TOPGEN], 1u);
            else XB_SPIN(xb_ld(&bar[XB_TOPGEN]) == tg, bar);
            __builtin_amdgcn_fence(__ATOMIC_ACQUIRE, "agent");
            xb_add(&bar[XB_XGEN(b.x)], 1u);
            asm volatile("s_waitcnt vmcnt(0)" ::: "memory");
        } else {
            XB_SPIN(xb_ld(&bar[XB_XGEN(b.x)]) == gen, bar);
            __builtin_amdgcn_fence(__ATOMIC_ACQUIRE, "agent");
            asm volatile("s_waitcnt vmcnt(0)" ::: "memory");
        }
    }
    __syncthreads();
}
__device__ __forceinline__ void p0_transpose_item(const float* W, const float* gk, int K, int N, bf16* WT, LAS float* scr, int item, int lane) {
    const int nblk = N / 32, kb = item / nblk, nb = item % nblk, k0 = 64 * kb, n0 = 32 * nb;
#pragma unroll 8
    for (int i = 0; i < 32; ++i) { const int kk = 2 * i + (lane >> 5); float w = W[(size_t)(k0 + kk) * N + n0 + (lane & 31)]; if (gk) w *= gk[k0 + kk]; scr[kk * 33 + (lane & 31)] = w; }
    asm volatile("s_waitcnt lgkmcnt(0)" ::: "memory");
    const int c = lane & 7;
#pragma unroll
    for (int j = 0; j < 4; ++j) { const int n = (lane >> 3) + 8 * j; const LAS float* s = scr + (8 * c) * 33 + n;
        v4u o; o.x = pk2(s[0 * 33], s[1 * 33]); o.y = pk2(s[2 * 33], s[3 * 33]); o.z = pk2(s[4 * 33], s[5 * 33]); o.w = pk2(s[6 * 33], s[7 * 33]);
        *(GAS v4u*)(WT + (size_t)(n0 + n) * K + k0 + 8 * c) = o; }
    asm volatile("s_waitcnt lgkmcnt(0)" ::: "memory");
}
__device__ __forceinline__ void rms_row_to_bf16(const float* xrow, bf16* orow, int lane) {
    const GAS f32x4* xr = (const GAS f32x4*)xrow + lane;
    f32x4 v[4]; float s = 0.f;
#pragma unroll
    for (int j = 0; j < 4; ++j) { v[j] = xr[64 * j]; s += (v[j].x * v[j].x + v[j].y * v[j].y) + (v[j].z * v[j].z + v[j].w * v[j].w); }
    const float rstd = 1.f / sqrtf(wave_sum(s) * (1.f / D) + RMS_EPS);
    GAS unsigned long long* o8 = (GAS unsigned long long*)orow + lane;
#pragma unroll
    for (int j = 0; j < 4; ++j) o8[64 * j] = (unsigned long long)pk2(v[j].x * rstd, v[j].y * rstd) | ((unsigned long long)pk2(v[j].z * rstd, v[j].w * rstd) << 32);
}
__device__ __forceinline__ void res_norm_row(const float* orow, const float* xrow, const float* g, float* x1row, bf16* xnrow, int lane) {
    const GAS f32x4* orr = (const GAS f32x4*)orow + lane; const GAS f32x4* xr = (const GAS f32x4*)xrow + lane; const GAS f32x4* gr = (const GAS f32x4*)g + lane;
    f32x4 v[4]; float s = 0.f;
#pragma unroll
    for (int j = 0; j < 4; ++j) { v[j] = orr[64 * j]; s += (v[j].x * v[j].x + v[j].y * v[j].y) + (v[j].z * v[j].z + v[j].w * v[j].w); }
    const float rstd = 1.f / sqrtf(wave_sum(s) * (1.f / D) + RMS_EPS);
    float s2 = 0.f;
#pragma unroll
    for (int j = 0; j < 4; ++j) { v[j] = xr[64 * j] + v[j] * rstd * gr[64 * j]; s2 += (v[j].x * v[j].x + v[j].y * v[j].y) + (v[j].z * v[j].z + v[j].w * v[j].w); }
    GAS f32x4* x1 = (GAS f32x4*)x1row + lane;
#pragma unroll
    for (int j = 0; j < 4; ++j) x1[64 * j] = v[j];
    if (xnrow) {
        const float rstd2 = 1.f / sqrtf(wave_sum(s2) * (1.f / D) + RMS_EPS);
        GAS unsigned long long* o8 = (GAS unsigned long long*)xnrow + lane;
#pragma unroll
        for (int j = 0; j < 4; ++j) o8[64 * j] = (unsigned long long)pk2(v[j].x * rstd2, v[j].y * rstd2) | ((unsigned long long)pk2(v[j].z * rstd2, v[j].w * rstd2) << 32);
    }
}

__device__ __forceinline__ int t5_bucket(int dist) {
    if (dist < 16) return dist;
    const int large = 16 + (int)(logf((float)dist / 16.0f) / logf(8.0f) * 16.0f);
    return large < 31 ? large : 31;
}
__device__ __forceinline__ void unpack8f(v4u w, float (&f)[8]) {
    f[0] = __uint_as_float(w.x << 16); f[1] = __uint_as_float(w.x & 0xffff0000u); f[2] = __uint_as_float(w.y << 16); f[3] = __uint_as_float(w.y & 0xffff0000u);
    f[4] = __uint_as_float(w.z << 16); f[5] = __uint_as_float(w.z & 0xffff0000u); f[6] = __uint_as_float(w.w << 16); f[7] = __uint_as_float(w.w & 0xffff0000u);
}
__device__ __forceinline__ void attn_simple_phase(const bf16* Q, const bf16* KV, bf16* ATT, const float* rel_bias, const float* sinks, int gw, int NGW, int lane) {
    const int bk0 = t5_bucket(lane), bk1 = t5_bucket(lane + 64);
    for (int unit = gw; unit < M * 8; unit += NGW) {
        const int m = unit >> 3, h = unit & 7, kvh = h >> 2, t = m & (SEQ - 1);
        const float qv = bf2f(Q[(size_t)m * 512 + h * 64 + lane]);
        const bool ok0 = (t - lane) >= 0, ok1 = (t - lane - 64) >= 0;
        const bf16* k0p = KV + (size_t)(m - (ok0 ? lane : 0)) * 256 + kvh * 64;
        const bf16* k1p = KV + (size_t)(m - (ok1 ? lane + 64 : 0)) * 256 + kvh * 64;
        float s0 = 0.f, s1 = 0.f;
#pragma unroll
        for (int d8 = 0; d8 < 8; ++d8) {
            float ka[8], kb[8]; unpack8f(*(const GAS v4u*)(k0p + d8 * 8), ka); unpack8f(*(const GAS v4u*)(k1p + d8 * 8), kb);
#pragma unroll
            for (int j = 0; j < 8; ++j) { const float qd = __shfl(qv, d8 * 8 + j); s0 += qd * ka[j]; s1 += qd * kb[j]; }
        }
        const float l0 = ok0 ? s0 + rel_bias[bk0 * 8 + h] : -1e30f, l1 = ok1 ? s1 + rel_bias[bk1 * 8 + h] : -1e30f;
        const float sink = sinks[h];
        const float mx = fmaxf(wave_max(fmaxf(l0, l1)), sink);
        float p0 = expf(l0 - mx), p1 = expf(l1 - mx);
        const float den = wave_sum(p0 + p1) + expf(sink - mx);
        p0 /= den; p1 /= den;
        float o = 0.f;
        const int nk = (t + 1) < 128 ? (t + 1) : 128;
        for (int dist = 0; dist < nk; ++dist) { const float pd = __shfl(dist < 64 ? p0 : p1, dist & 63); o += pd * bf2f(KV[(size_t)(m - dist) * 256 + 128 + kvh * 64 + lane]); }
        ATT[(size_t)m * 512 + h * 64 + lane] = (bf16)f2bf(o);
    }
}

__device__ __forceinline__ float gelu_tanh(float y) { return 0.5f * y * (1.0f + tanhf(0.7978845608028654f * (y + 0.044715f * y * y * y))); }
__device__ __forceinline__ void ssm_consts(int g, int p, const float* lam_re, const float* lam_im, const float* log_dt, const float* b_re, const float* b_im,
                                           float& abr, float& abi, float (&bbr)[16], float (&bbi)[16]) {
    const float dt = expf(log_dt[g]);
    const float lr = lam_re[g * 64 + p], li = lam_im[g * 64 + p];
    const float mag = expf(lr * dt);
    abr = mag * cosf(li * dt); abi = mag * sinf(li * dt);
    const float nr = abr - 1.0f, den = lr * lr + li * li;
    const float fr = (nr * lr + abi * li) / den, fi = (abi * lr - nr * li) / den;
#pragma unroll
    for (int c = 0; c < 16; ++c) { const float br = b_re[(size_t)(g * 64 + p) * 16 + c], bi = b_im[(size_t)(g * 64 + p) * 16 + c]; bbr[c] = fr * br - fi * bi; bbi[c] = fr * bi + fi * br; }
}
__device__ __forceinline__ void load_u16(const bf16* up, float (&uv)[16]) {
    float a[8], b[8]; unpack8f(*(const GAS v4u*)up, a); unpack8f(*(const GAS v4u*)(up + 8), b);
#pragma unroll
    for (int c = 0; c < 8; ++c) { uv[c] = a[c]; uv[8 + c] = b[c]; }
}
__device__ __forceinline__ void ssm_state_phase(const bf16* U, float* S, const float* lam_re, const float* lam_im, const float* log_dt, const float* b_re, const float* b_im, int gw, int NGW, int lane) {
    for (int unit = gw; unit < NB * NCH * 32; unit += NGW) {
        const int g = unit & 31, j = (unit >> 5) & (NCH - 1), b = unit >> 11;
        float abr, abi, bbr[16], bbi[16];
        ssm_consts(g, lane, lam_re, lam_im, log_dt, b_re, b_im, abr, abi, bbr, bbi);
        float hr = 0.f, hi = 0.f;
        const bf16* up = U + (size_t)(b * SEQ + j * TCH) * 512 + g * 16;
        for (int s = 0; s < TCH; ++s) {
            float uv[16]; load_u16(up + (size_t)s * 512, uv);
            float bur = 0.f, bui = 0.f;
#pragma unroll
            for (int c = 0; c < 16; ++c) { bur += bbr[c] * uv[c]; bui += bbi[c] * uv[c]; }
            const float nr = abr * hr - abi * hi + bur, ni = abr * hi + abi * hr + bui; hr = nr; hi = ni;
        }
        float* sp = S + ((size_t)(b * NCH + j) * 32 + g) * 128;
        sp[lane] = hr; sp[64 + lane] = hi;
    }
}
__device__ __forceinline__ void ssm_out_phase(const bf16* U, const float* S, bf16* Z, const float* lam_re, const float* lam_im, const float* log_dt, const float* b_re, const float* b_im,
                                              const float* c_re, const float* c_im, const float* d_skip, int gw, int NGW, int lane) {
    for (int unit = gw; unit < NB * NCH * 32; unit += NGW) {
        const int g = unit & 31, j = (unit >> 5) & (NCH - 1), b = unit >> 11;
        float abr, abi, bbr[16], bbi[16], cr[16], ci[16];
        ssm_consts(g, lane, lam_re, lam_im, log_dt, b_re, b_im, abr, abi, bbr, bbi);
#pragma unroll
        for (int c = 0; c < 16; ++c) { cr[c] = c_re[(size_t)(g * 16 + c) * 64 + lane]; ci[c] = c_im[(size_t)(g * 16 + c) * 64 + lane]; }
        const float dsk = d_skip[g * 16 + (lane & 15)];
        float aTr = abr, aTi = abi;
#pragma unroll
        for (int q = 0; q < 6; ++q) { const float r2 = aTr * aTr - aTi * aTi, i2 = 2.f * aTr * aTi; aTr = r2; aTi = i2; }
        float hr = 0.f, hi = 0.f;
        const float* sp = S + ((size_t)(b * NCH) * 32 + g) * 128 + lane;
        for (int m2 = 0; m2 < j; ++m2) { const float sr = sp[(size_t)m2 * 4096], si = sp[(size_t)m2 * 4096 + 64]; const float nr = aTr * hr - aTi * hi + sr, ni = aTr * hi + aTi * hr + si; hr = nr; hi = ni; }
        const bf16* up = U + (size_t)(b * SEQ + j * TCH) * 512 + g * 16;
        bf16* zp = Z + (size_t)(b * SEQ + j * TCH) * 512 + g * 16;
        for (int s = 0; s < TCH; ++s) {
            float uv[16]; load_u16(up + (size_t)s * 512, uv);
            float bur = 0.f, bui = 0.f, umine = 0.f;
#pragma unroll
            for (int c = 0; c < 16; ++c) { bur += bbr[c] * uv[c]; bui += bbi[c] * uv[c]; umine = ((lane & 15) == c) ? uv[c] : umine; }
            const float nr = abr * hr - abi * hi + bur, ni = abr * hi + abi * hr + bui; hr = nr; hi = ni;
            float ymine = 0.f;
#pragma unroll
            for (int c = 0; c < 16; ++c) { const float y = wave_sum(cr[c] * hr - ci[c] * hi); ymine = (lane == c) ? y : ymine; }
            if (lane < 16) zp[(size_t)s * 512 + lane] = (bf16)f2bf(gelu_tanh(ymine + dsk * umine));
        }
    }
}
typedef short bf16x8v __attribute__((ext_vector_type(8)));
__device__ __forceinline__ unsigned cvtpk(float lo, float hi) { unsigned r; asm volatile("v_cvt_pk_bf16_f32 %0, %1, %2" : "=v"(r) : "v"(lo), "v"(hi)); return r; }
__device__ __forceinline__ bf16x8v pack8v(const float (&f)[8]) { v4u w; w.x = cvtpk(f[0], f[1]); w.y = cvtpk(f[2], f[3]); w.z = cvtpk(f[4], f[5]); w.w = cvtpk(f[6], f[7]); return __builtin_bit_cast(bf16x8v, w); }
constexpr float LOG2E = 1.4426950408889634f;

__device__ __forceinline__ void ssm_tables_unit(int g, int p, const float* lam_re, const float* lam_im, const float* log_dt, const float* b_re, const float* b_im, float* PWr, float* PWi, float* BBr, float* BBi) {
    float abr, abi, bbr[16], bbi[16];
    ssm_consts(g, p, lam_re, lam_im, log_dt, b_re, b_im, abr, abi, bbr, bbi);
#pragma unroll
    for (int c = 0; c < 16; ++c) { BBr[(size_t)(g * 64 + p) * 16 + c] = bbr[c]; BBi[(size_t)(g * 64 + p) * 16 + c] = bbi[c]; }
    double pr = 1.0, pi = 0.0; const double ar = (double)abr, ai = (double)abi;
    for (int tau = 0; tau <= 64; ++tau) { PWr[(size_t)(g * 65 + tau) * 64 + p] = (float)pr; PWi[(size_t)(g * 65 + tau) * 64 + p] = (float)pi; const double nr = pr * ar - pi * ai, ni = pr * ai + pi * ar; pr = nr; pi = ni; }
}
__device__ __forceinline__ void ssm_ktab_phase(const float* PWr, const float* PWi, const float* BBr, const float* BBi, const float* c_re, const float* c_im, bf16* Ktab, int gw, int NGW, int lane) {
    for (int unit = gw; unit < 32 * 16; unit += NGW) {
        const int g = unit >> 4, tau = (unit & 15) * 4 + (lane >> 4), cp = lane & 15;
        float acc[16];
#pragma unroll
        for (int c = 0; c < 16; ++c) acc[c] = 0.f;
        for (int p = 0; p < 64; ++p) {
            const float pr = PWr[(size_t)(g * 65 + tau) * 64 + p], pi = PWi[(size_t)(g * 65 + tau) * 64 + p];
            const float br = BBr[(size_t)(g * 64 + p) * 16 + cp], bi = BBi[(size_t)(g * 64 + p) * 16 + cp];
            const float xr = pr * br - pi * bi, xi = pr * bi + pi * br;
#pragma unroll
            for (int c = 0; c < 16; ++c) acc[c] += c_re[(size_t)(g * 16 + c) * 64 + p] * xr - c_im[(size_t)(g * 16 + c) * 64 + p] * xi;
        }
#pragma unroll
        for (int c = 0; c < 16; ++c) Ktab[((size_t)(g * 64 + tau) * 16 + c) * 16 + cp] = (bf16)f2bf(acc[c]);
    }
}

template <int SEG> __device__ __forceinline__ void conv_seg(LAS unsigned char* L3, LAS unsigned char* ub, f32x4 (&acc)[4], int l15, int lh, int lo) {
#pragma unroll 2
    for (int t2 = 8 * SEG; t2 < 8 * SEG + 8; ++t2) {
        const int tau0 = 2 * t2;
        const bf16x8v Kf = *(const LAS bf16x8v*)(L3 + (tau0 + lh) * 512 + l15 * 32 + lo * 16);
#pragma unroll
        for (int i = SEG; i < 4; ++i) {
            const bf16x8v Yf = *(const LAS bf16x8v*)(ub + (64 + 16 * i - tau0 + l15 - lh) * 32 + lo * 16);
            acc[i] = __builtin_amdgcn_mfma_f32_16x16x32_bf16(Kf, Yf, acc[i], 0, 0, 0);
        }
    }
}
__device__ __forceinline__ void ssm_y_phase(LAS unsigned char* L3, const bf16* U, const float* S, bf16* Z, const bf16* Ktab, const float* PWr, const float* PWi,
                                            const float* c_re, const float* c_im, const float* d_skip, int G, int vcu, int tid, int lane, int wave) {
    const int l15 = lane & 15, lq = lane >> 4, lh = lane >> 5, lo = (lane >> 4) & 1;
    LAS unsigned char* ub = L3 + 32768 + wave * 6144; LAS float* hb = (LAS float*)(ub + 4096);
    for (int bu = vcu; bu < 256; bu += G) {
        const int g = bu >> 3, b = (bu >> 1) & 3, hf = bu & 1;
        __syncthreads();
        for (int i = tid; i < 2048; i += 512) *(LAS v4u*)(L3 + i * 16) = *(const GAS v4u*)(Ktab + (size_t)g * 16384 + i * 8);
        *(LAS v4u*)(ub + lane * 16) = (v4u){0u, 0u, 0u, 0u}; *(LAS v4u*)(ub + 1024 + lane * 16) = (v4u){0u, 0u, 0u, 0u};
        __syncthreads();
        const float a16r = PWr[(size_t)(g * 65 + 16) * 64 + lane], a16i = PWi[(size_t)(g * 65 + 16) * 64 + lane];
        const float aTr = PWr[(size_t)(g * 65 + 64) * 64 + lane], aTi = PWi[(size_t)(g * 65 + 64) * 64 + lane];
        float pwr[2][8], pwi[2][8]; bf16x8v Cf[4];
#pragma unroll
        for (int ks = 0; ks < 2; ++ks) {
            const size_t o = (size_t)(g * 65 + l15 + 1) * 64 + 32 * ks + 8 * lq;
            const f32x4 r0 = *(const GAS f32x4*)(PWr + o), r1 = *(const GAS f32x4*)(PWr + o + 4), i0 = *(const GAS f32x4*)(PWi + o), i1 = *(const GAS f32x4*)(PWi + o + 4);
#pragma unroll
            for (int j = 0; j < 4; ++j) { pwr[ks][j] = r0[j]; pwr[ks][4 + j] = r1[j]; pwi[ks][j] = i0[j]; pwi[ks][4 + j] = i1[j]; }
            const size_t oc = (size_t)(g * 16 + l15) * 64 + 32 * ks + 8 * lq;
            const f32x4 c0 = *(const GAS f32x4*)(c_re + oc), c1 = *(const GAS f32x4*)(c_re + oc + 4), d0 = *(const GAS f32x4*)(c_im + oc), d1 = *(const GAS f32x4*)(c_im + oc + 4);
            float t[8], s[8];
#pragma unroll
            for (int j = 0; j < 4; ++j) { t[j] = c0[j]; t[4 + j] = c1[j]; s[j] = -d0[j]; s[4 + j] = -d1[j]; }
            Cf[ks] = pack8v(t); Cf[ks + 2] = pack8v(s);
        }
        float dsk[4];
#pragma unroll
        for (int r = 0; r < 4; ++r) dsk[r] = d_skip[g * 16 + 4 * lq + r];
        const int j0 = hf * 32 + wave * 4;
        float Hr = 0.f, Hi = 0.f;
        { const float* sp = S + ((size_t)(b * NCH) * 32 + g) * 128 + lane;
          for (int m0 = 0; m0 < j0; m0 += 4) { float sr[4], si[4];
#pragma unroll
              for (int q = 0; q < 4; ++q) { sr[q] = sp[(size_t)(m0 + q) * 4096]; si[q] = sp[(size_t)(m0 + q) * 4096 + 64]; }
#pragma unroll
              for (int q = 0; q < 4; ++q) { const float nr = aTr * Hr - aTi * Hi + sr[q], ni = aTr * Hi + aTi * Hr + si[q]; Hr = nr; Hi = ni; } } }
        for (int jj = 0; jj < 4; ++jj) {
            const int j = j0 + jj; const size_t row0 = (size_t)b * SEQ + (size_t)j * TCH;
            { const bf16* up = U + (row0 + lane) * 512 + g * 16; const v4u u0 = *(const GAS v4u*)up, u1 = *(const GAS v4u*)(up + 8);
              *(LAS v4u*)(ub + (64 + lane) * 32) = u0; *(LAS v4u*)(ub + (64 + lane) * 32 + 16) = u1; }
            { float xr = Hr, xi = Hi;
#pragma unroll
              for (int i = 0; i < 4; ++i) { hb[i * 128 + lane] = xr; hb[i * 128 + 64 + lane] = xi; const float nr = a16r * xr - a16i * xi, ni = a16r * xi + a16i * xr; xr = nr; xi = ni; } }
            const float snr = S[((size_t)(b * NCH + j) * 32 + g) * 128 + lane], sni = S[((size_t)(b * NCH + j) * 32 + g) * 128 + 64 + lane];
            asm volatile("s_waitcnt lgkmcnt(0)" ::: "memory");
            f32x4 acc[4];
#pragma unroll
            for (int i = 0; i < 4; ++i) acc[i] = (f32x4){0.f, 0.f, 0.f, 0.f};
            conv_seg<0>(L3, ub, acc, l15, lh, lo); conv_seg<1>(L3, ub, acc, l15, lh, lo); conv_seg<2>(L3, ub, acc, l15, lh, lo); conv_seg<3>(L3, ub, acc, l15, lh, lo);
#pragma unroll
            for (int i = 0; i < 4; ++i)
#pragma unroll
                for (int ks = 0; ks < 2; ++ks) {
                    const LAS float* hp = hb + i * 128 + 32 * ks + 8 * lq;
                    const f32x4 h0 = *(const LAS f32x4*)hp, h1 = *(const LAS f32x4*)(hp + 4), g0 = *(const LAS f32x4*)(hp + 64), g1 = *(const LAS f32x4*)(hp + 68);
                    float re[8], im[8];
#pragma unroll
                    for (int q = 0; q < 4; ++q) {
                        re[q] = pwr[ks][q] * h0[q] - pwi[ks][q] * g0[q]; im[q] = pwr[ks][q] * g0[q] + pwi[ks][q] * h0[q];
                        re[4 + q] = pwr[ks][4 + q] * h1[q] - pwi[ks][4 + q] * g1[q]; im[4 + q] = pwr[ks][4 + q] * g1[q] + pwi[ks][4 + q] * h1[q]; }
                    acc[i] = __builtin_amdgcn_mfma_f32_16x16x32_bf16(Cf[ks], pack8v(re), acc[i], 0, 0, 0);
                    acc[i] = __builtin_amdgcn_mfma_f32_16x16x32_bf16(Cf[ks + 2], pack8v(im), acc[i], 0, 0, 0);
                }
#pragma unroll
            for (int i = 0; i < 4; ++i) {
                const int t = 16 * i + l15;
                const unsigned long long uw = *(const LAS unsigned long long*)(ub + (64 + t) * 32 + lq * 8);
                const unsigned w0 = (unsigned)uw, w1 = (unsigned)(uw >> 32);
                const float y0 = gelu_tanh(acc[i][0] + dsk[0] * __uint_as_float(w0 << 16)), y1 = gelu_tanh(acc[i][1] + dsk[1] * __uint_as_float(w0 & 0xffff0000u));
                const float y2 = gelu_tanh(acc[i][2] + dsk[2] * __uint_as_float(w1 << 16)), y3 = gelu_tanh(acc[i][3] + dsk[3] * __uint_as_float(w1 & 0xffff0000u));
                *(GAS unsigned long long*)(Z + (row0 + t) * 512 + g * 16 + 4 * lq) = (unsigned long long)cvtpk(y0, y1) | ((unsigned long long)cvtpk(y2, y3) << 32);
            }
            asm volatile("s_waitcnt lgkmcnt(0)" ::: "memory");
            { const float nr = aTr * Hr - aTi * Hi + snr, ni = aTr * Hi + aTi * Hr + sni; Hr = nr; Hi = ni; }
        }
    }
}
constexpr int AT_KB = 0, AT_VT = 36864;
__device__ __forceinline__ void attn_mfma_phase(LAS unsigned char* L3, const bf16* Q, const bf16* KV, bf16* ATT, const float* rel_bias, const float* sinks, int G, int vcu, int tid, int lane, int wave) {
    const int l15 = lane & 15, lq = lane >> 4, hq = wave >> 1, half = wave & 1;
    for (int bu = vcu; bu < 256; bu += G) {
        const int kvh = bu & 1, nb = (bu >> 1) & 31, b = bu >> 6, h = kvh * 4 + hq;
        const size_t rowc = (size_t)b * SEQ + (size_t)nb * 128;
        __syncthreads();
        for (int i = tid; i < 2048; i += 512) { const int key = i >> 3, ch = i & 7; v4u v = (v4u){0u, 0u, 0u, 0u};
            if (nb > 0 || key >= 128) v = *(const GAS v4u*)(KV + (rowc + key - 128) * 256 + kvh * 64 + ch * 8);
            *(LAS v4u*)(L3 + AT_KB + key * 144 + ch * 16) = v; }
        for (int i = tid; i < 2048; i += 512) { const int key = i & 255, ch = i >> 8; v4u v = (v4u){0u, 0u, 0u, 0u};
            if (nb > 0 || key >= 128) v = *(const GAS v4u*)(KV + (rowc + key - 128) * 256 + 128 + kvh * 64 + ch * 8);
            LAS bf16* vt = (LAS bf16*)(L3 + AT_VT) + (ch * 8) * 264 + key;
            vt[0 * 264] = (bf16)(v.x & 0xffffu); vt[1 * 264] = (bf16)(v.x >> 16); vt[2 * 264] = (bf16)(v.y & 0xffffu); vt[3 * 264] = (bf16)(v.y >> 16);
            vt[4 * 264] = (bf16)(v.z & 0xffffu); vt[5 * 264] = (bf16)(v.z >> 16); vt[6 * 264] = (bf16)(v.w & 0xffffu); vt[7 * 264] = (bf16)(v.w >> 16); }
        __syncthreads();
        float bias[9][4];
#pragma unroll
        for (int dk = 0; dk < 9; ++dk)
#pragma unroll
            for (int r = 0; r < 4; ++r) { const int dist = 128 + l15 - 4 * lq - 16 * dk - r; bias[dk][r] = (dist >= 0 && dist < 128) ? rel_bias[t5_bucket(dist) * 8 + h] * LOG2E : -1e30f; }
        const float sinkv = sinks[h] * LOG2E;
#pragma unroll 1
        for (int qt = 0; qt < 4; ++qt) {
            const size_t qrow = rowc + 64 * half + 16 * qt + l15;
            const bf16x8v Qf0 = *(const GAS bf16x8v*)(Q + qrow * 512 + h * 64 + 8 * lq), Qf1 = *(const GAS bf16x8v*)(Q + qrow * 512 + h * 64 + 32 + 8 * lq);
            f32x4 sc[9]; float mx = -1e30f;
#pragma unroll
            for (int dk = 0; dk < 9; ++dk) {
                const int kj0 = 64 * half + 16 * (qt + dk);
                const LAS unsigned char* kp = L3 + AT_KB + (kj0 + l15) * 144 + lq * 16;
                f32x4 a = (f32x4){0.f, 0.f, 0.f, 0.f};
                a = __builtin_amdgcn_mfma_f32_16x16x32_bf16(*(const LAS bf16x8v*)kp, Qf0, a, 0, 0, 0);
                a = __builtin_amdgcn_mfma_f32_16x16x32_bf16(*(const LAS bf16x8v*)(kp + 64), Qf1, a, 0, 0, 0);
#pragma unroll
                for (int r = 0; r < 4; ++r) { float s = a[r] + bias[dk][r]; if (nb == 0 && kj0 + 4 * lq + r < 128) s = -1e30f; a[r] = s; mx = fmaxf(mx, s); }
                sc[dk] = a;
            }
            mx = fmaxf(mx, __shfl_xor(mx, 16)); mx = fmaxf(mx, __shfl_xor(mx, 32)); mx = fmaxf(mx, sinkv);
            float sum = 0.f;
#pragma unroll
            for (int dk = 0; dk < 9; ++dk)
#pragma unroll
                for (int r = 0; r < 4; ++r) { const float p = __builtin_amdgcn_exp2f(sc[dk][r] - mx); sc[dk][r] = p; sum += p; }
            sum += __shfl_xor(sum, 16); sum += __shfl_xor(sum, 32); sum += __builtin_amdgcn_exp2f(sinkv - mx);
            f32x4 o[4];
#pragma unroll
            for (int dt = 0; dt < 4; ++dt) o[dt] = (f32x4){0.f, 0.f, 0.f, 0.f};
#pragma unroll
            for (int pr = 0; pr < 5; ++pr) {
                float pf[8];
#pragma unroll
                for (int r = 0; r < 4; ++r) { pf[r] = sc[2 * pr][r]; pf[4 + r] = (pr < 4) ? sc[(pr < 4) ? 2 * pr + 1 : 0][r] : 0.f; }
                const bf16x8v Pf = pack8v(pf);
                const int keyA = 64 * half + 16 * (qt + 2 * pr) + 4 * lq;
#pragma unroll
                for (int dt = 0; dt < 4; ++dt) {
                    const LAS bf16* vp = (const LAS bf16*)(L3 + AT_VT) + (16 * dt + l15) * 264 + keyA;
                    const unsigned long long va = *(const LAS unsigned long long*)vp;
                    const unsigned long long vb = (pr < 4) ? *(const LAS unsigned long long*)(vp + 16) : 0ull;
                    v4u w; w.x = (unsigned)va; w.y = (unsigned)(va >> 32); w.z = (unsigned)vb; w.w = (unsigned)(vb >> 32);
                    o[dt] = __builtin_amdgcn_mfma_f32_16x16x32_bf16(__builtin_bit_cast(bf16x8v, w), Pf, o[dt], 0, 0, 0);
                }
            }
            const float inv = 1.0f / sum;
#pragma unroll
            for (int dt = 0; dt < 4; ++dt)
                *(GAS unsigned long long*)(ATT + qrow * 512 + h * 64 + 16 * dt + 4 * lq) = (unsigned long long)cvtpk(o[dt][0] * inv, o[dt][1] * inv) | ((unsigned long long)cvtpk(o[dt][2] * inv, o[dt][3] * inv) << 32);
        }
    }
}
struct Args { const float* in[22]; float* out; unsigned char* ws; };
__global__ void __launch_bounds__(NWAVES * 64, 2) mk_fwd(Args args) {
    extern __shared__ __attribute__((aligned(16))) unsigned char lds[];
    LAS unsigned char* const L3 = (LAS unsigned char*)lds;
    volatile LAS unsigned* const MISC = (volatile LAS unsigned*)(L3 + MISC_OFF);
    const int tid = threadIdx.x, lane = tid & 63, wave = __builtin_amdgcn_readfirstlane(tid >> 6);
    const int G = gridDim.x; const int bx = blockIdx.x; const int vcu = (G % 8 == 0) ? (bx % 8) * (G / 8) + bx / 8 : bx;
    const int gw = vcu * NWAVES + wave, NGW = G * NWAVES;
    unsigned char* const ws = args.ws;
    const float* x = args.in[0];
    const float *g_pre = args.in[1], *g_post = args.in[2], *g_mpre = args.in[3], *g_mpost = args.in[4];
    const float *w_in = args.in[5], *rel_bias = args.in[6], *sinks = args.in[7];
    const float *lam_re = args.in[8], *lam_im = args.in[9], *log_dt = args.in[10], *b_re = args.in[11], *b_im = args.in[12], *c_re = args.in[13], *c_im = args.in[14], *d_skip = args.in[15];
    const float *w_glu = args.in[16], *w_ab = args.in[17], *w_sb = args.in[18], *w_out = args.in[19], *w_ff1 = args.in[20], *w_ff2 = args.in[21];
    float* const out = args.out;
    bf16 *Win_t = (bf16*)(ws + WS_WIN), *Wglu_t = (bf16*)(ws + WS_WGLU), *Wab_t = (bf16*)(ws + WS_WAB), *Wsb_t = (bf16*)(ws + WS_WSB), *Wout_t = (bf16*)(ws + WS_WOUT), *Wff1_t = (bf16*)(ws + WS_WFF1), *Wff2_t = (bf16*)(ws + WS_WFF2);
    bf16 *XN = (bf16*)(ws + WS_XN), *Qb = (bf16*)(ws + WS_Q), *KVb = (bf16*)(ws + WS_KV), *Ub = (bf16*)(ws + WS_U), *GA = (bf16*)(ws + WS_GA), *GS = (bf16*)(ws + WS_GS);
    bf16 *ATT = (bf16*)(ws + WS_ATT), *Zb = (bf16*)(ws + WS_Z), *Z2 = (bf16*)(ws + WS_Z2), *YA = (bf16*)(ws + WS_YA), *MG = (bf16*)(ws + WS_MG), *F1 = (bf16*)(ws + WS_F1);
    float *Sst = (float*)(ws + WS_S), *Ob = (float*)(ws + WS_O), *F2 = (float*)(ws + WS_F2);
    bf16* Ktab = (bf16*)(ws + WS_KTAB); float *PWr = (float*)(ws + WS_PWR), *PWi = (float*)(ws + WS_PWI), *BBr = (float*)(ws + WS_BBR), *BBi = (float*)(ws + WS_BBI);

    for (int u = tid; u < (LDS_BYTES - LDSCTL_OFF) / 4; u += NWAVES * 64) ((LAS unsigned*)(L3 + LDSCTL_OFF))[u] = 0u;
    __syncthreads();
    const XcdBarrier bar = xcd_barrier_post((unsigned*)(ws + WS_CTL) + CW_BAR, MISC + 8);

    {
        LAS float* scr = (LAS float*)(L3 + wave * 16384);
        constexpr int I_IN = (D / 64) * (INW / 32), I_GLU = (512 / 64) * (512 / 32), I_AB = (512 / 64) * (D / 32), I_SB = I_AB, I_OUT = (D / 64) * (D / 32), I_F1 = (D / 64) * (DFF / 32), I_F2 = (DFF / 64) * (D / 32);
        constexpr int NITEMS = I_IN + I_GLU + I_AB + I_SB + I_OUT + I_F1 + I_F2;
        for (int it = gw; it < NITEMS; it += NGW) {
            int r = it;
            if (r < I_IN) { p0_transpose_item(w_in, g_pre, D, INW, Win_t, scr, r, lane); continue; } r -= I_IN;
            if (r < I_GLU) { p0_transpose_item(w_glu, nullptr, 512, 512, Wglu_t, scr, r, lane); continue; } r -= I_GLU;
            if (r < I_AB) { p0_transpose_item(w_ab, nullptr, 512, D, Wab_t, scr, r, lane); continue; } r -= I_AB;
            if (r < I_SB) { p0_transpose_item(w_sb, nullptr, 512, D, Wsb_t, scr, r, lane); continue; } r -= I_SB;
            if (r < I_OUT) { p0_transpose_item(w_out, nullptr, D, D, Wout_t, scr, r, lane); continue; } r -= I_OUT;
            if (r < I_F1) { p0_transpose_item(w_ff1, g_mpre, D, DFF, Wff1_t, scr, r, lane); continue; } r -= I_F1;
            p0_transpose_item(w_ff2, nullptr, DFF, D, Wff2_t, scr, r, lane);
        }
        for (int m = gw; m < M; m += NGW) rms_row_to_bf16(x + (size_t)m * D, XN + (size_t)m * D, lane);
        if (gw >= NGW - 32) ssm_tables_unit(gw - (NGW - 32), lane, lam_re, lam_im, log_dt, b_re, b_im, PWr, PWi, BBr, BBi);
    }
    xcd_barrier(bar);

    {
        pg8::Gemm g{XN, Win_t, M, INW, D}; pg8::StaticOrder S; S.init(M, INW, G, bx);
        pg8::EpiProj E{Qb, KVb, Ub, GA, GS};
        pg8::gemm_phase<pg8::EpiProj, pg8::StaticOrder, true, true>(L3, g, S, E);
    }
    xcd_barrier(bar);

    ssm_ktab_phase(PWr, PWi, BBr, BBi, c_re, c_im, Ktab, gw, NGW, lane);
    attn_mfma_phase(L3, Qb, KVb, ATT, rel_bias, sinks, G, vcu, tid, lane, wave);
    ssm_state_phase(Ub, Sst, lam_re, lam_im, log_dt, b_re, b_im, gw, NGW, lane);
    xcd_barrier(bar);

    ssm_y_phase(L3, Ub, Sst, Zb, Ktab, PWr, PWi, c_re, c_im, d_skip, G, vcu, tid, lane, wave);
    xcd_barrier(bar);

    {
        pg8::Gemm g{Zb, Wglu_t, M, 512, 512}; pg8::StaticOrder S; S.init(M, 512, G, bx);
        pg8::EpiGlu E{Zb, Z2};
        pg8::gemm_phase<pg8::EpiGlu, pg8::StaticOrder, true, true>(L3, g, S, E);
    }
    {
        pg8::Gemm g{ATT, Wab_t, M, D, 512}; pg8::StaticOrder S; S.init(M, D, G, bx);
        pg8::EpiGate E{GA, nullptr, YA};
        pg8::gemm_phase<pg8::EpiGate, pg8::StaticOrder, true, true>(L3, g, S, E);
    }
    xcd_barrier(bar);

    {
        pg8::Gemm g{Z2, Wsb_t, M, D, 512}; pg8::StaticOrder S; S.init(M, D, G, bx);
        pg8::EpiGate E{GS, YA, MG};
        pg8::gemm_phase<pg8::EpiGate, pg8::StaticOrder, true, true>(L3, g, S, E);
    }
    xcd_barrier(bar);

    {
        pg8::Gemm g{MG, Wout_t, M, D, D}; pg8::StaticOrder S; S.init(M, D, G, bx);
        pg8::EpiF32 E{Ob, D};
        pg8::gemm_phase<pg8::EpiF32, pg8::StaticOrder, true, true>(L3, g, S, E);
    }
    xcd_barrier(bar);
    for (int m = gw; m < M; m += NGW) res_norm_row(Ob + (size_t)m * D, x + (size_t)m * D, g_post, out + (size_t)m * D, XN + (size_t)m * D, lane);
    xcd_barrier(bar);

    {
        pg8::Gemm g{XN, Wff1_t, M, DFF, D}; pg8::StaticOrder S; S.init(M, DFF, G, bx);
        pg8::EpiRelu2 E{F1, DFF};
        pg8::gemm_phase<pg8::EpiRelu2, pg8::StaticOrder, true, true>(L3, g, S, E);
    }
    xcd_barrier(bar);

    {
        pg8::Gemm g{F1, Wff2_t, M, D, DFF}; pg8::StaticOrder S; S.init(M, D, G, bx);
        pg8::EpiF32 E{F2, D};
        pg8::gemm_phase<pg8::EpiF32, pg8::StaticOrder, true, true>(L3, g, S, E);
    }
    xcd_barrier(bar);
    for (int m = gw; m < M; m += NGW) res_norm_row(F2 + (size_t)m * D, out + (size_t)m * D, g_mpost, out + (size_t)m * D, nullptr, lane);
}

extern "C" void kernel_launch(void* const* d_in, const int* in_sizes, int n_in, void* d_out, int out_size, void* d_ws, size_t ws_size, hipStream_t stream) {
    static int grid = 0;
    if (grid == 0) {
        if (n_in != 22 || in_sizes[0] != M * D || out_size != M * D || ws_size < WS_END) { fprintf(stderr, "kernel_launch: unexpected shapes (n_in %d, in0 %d, out %d, ws %zu)\n", n_in, n_in > 0 ? in_sizes[0] : -1, out_size, ws_size); grid = -1; return; }
        int dev = 0, cus = 0, per_cu = 0;
        if (hipGetDevice(&dev) != hipSuccess || hipDeviceGetAttribute(&cus, hipDeviceAttributeMultiprocessorCount, dev) != hipSuccess) { grid = -1; return; }
        if (hipFuncSetAttribute((const void*)mk_fwd, hipFuncAttributeMaxDynamicSharedMemorySize, LDS_BYTES) != hipSuccess) { fprintf(stderr, "kernel_launch: hipFuncSetAttribute failed\n"); grid = -1; return; }
        if (hipOccupancyMaxActiveBlocksPerMultiprocessor(&per_cu, (const void*)mk_fwd, NWAVES * 64, LDS_BYTES) != hipSuccess || per_cu < 1) fprintf(stderr, "kernel_launch: occupancy query reports %d workgroups per CU\n", per_cu);
        (void)hipGetLastError();
        grid = cus;
    }
    if (grid < 0) return;
    if (hipMemsetAsync((char*)d_ws + WS_CTL, 0, CTL_ZERO_BYTES, stream) != hipSuccess) { fprintf(stderr, "kernel_launch: memset failed\n"); return; }
    Args a{};
    for (int i = 0; i < 22; ++i) a.in[i] = (const float*)d_in[i];
    a.out = (float*)d_out; a.ws = (unsigned char*)d_ws;
    hipLaunchKernelGGL(mk_fwd, dim3(grid), dim3(NWAVES * 64), LDS_BYTES, stream, a);
    const hipError_t le = hipPeekAtLastError();
    if (le != hipSuccess) fprintf(stderr, "kernel_launch: launch failed: %s\n", hipGetErrorName(le));
}
```

```cpp
#include <hip/hip_runtime.h>
#include <cstdio>
#include <cstdint>
#include <cmath>
#define PROBE_DUP -1
namespace pg8 {
#define PG8_LAS __attribute__((address_space(3)))
typedef unsigned short bf16_t;
typedef short bf16x8 __attribute__((ext_vector_type(8)));
typedef float f32x4 __attribute__((ext_vector_type(4)));
typedef unsigned u32x4 __attribute__((ext_vector_type(4)));
constexpr int BM = 256, BK = 64, HALF = 128, HTB = HALF * BK * 2  , STAGE_BYTES = 8 * HTB, NXCD = 8, WGM = 8;

__host__ __device__ __forceinline__ int lds_byte(int r, int c) { const int st = (r >> 4) * 2 + (c >> 5), rr = r & 15, cc = c & 31, ob = rr * 64 + cc * 2; return st * 1024 + (ob ^ (((ob >> 9) & 1) << 5)); }
__host__ __device__ __forceinline__ void stage_rc(int b, int& R, int& C) { const int st = b / 1024, sb = b % 1024, swz = sb ^ (((sb >> 9) & 1) << 5); R = (st >> 1) * 16 + swz / 64; C = (st & 1) * 32 + (swz % 64) / 2; }
__host__ __device__ __forceinline__ int perm32(int rho) { const int n = rho >> 4, i = rho & 15; return 8 * (i >> 2) + 4 * n + (i & 3); }

struct Unit { int pm, pn; };
struct Gemm { const bf16_t* A; const bf16_t* Bt; int M, N, K; };

struct StaticOrder {
    int nM, nN, nwg, G, c;
    __host__ __device__ void init(int M, int N, int G_, int c_) { nM = M / BM; nN = N / BM; nwg = nM * nN; G = G_; c = c_; }
    __host__ __device__ bool next(int i, Unit& u) const {
        const long L = (long)i * G + c; if (L >= nwg) return false;
        int wgid = (int)L; { const int q = nwg / NXCD, r = nwg % NXCD, xcd = wgid % NXCD, off = wgid / NXCD; wgid = (xcd < r ? xcd * (q + 1) : r * (q + 1) + (xcd - r) * q) + off; }
        const int nig = WGM * nN, gid = wgid / nig, fm = gid * WGM, gsz = (nM - fm) < WGM ? (nM - fm) : WGM;
        u.pm = fm + ((wgid % nig) % gsz); u.pn = (wgid % nig) / gsz; return true;
    }
    __device__ __forceinline__ void a_ready(const Unit&) const {}
    __device__ __forceinline__ void done(const Unit&) const {}
};
__device__ __forceinline__ unsigned cvt_pk_bf16(float lo, float hi) { unsigned r; asm volatile("v_cvt_pk_bf16_f32 %0, %1, %2" : "=v"(r) : "v"(lo), "v"(hi)); return r; }
typedef float f32x2 __attribute__((ext_vector_type(2)));
__device__ __forceinline__ float bf_lo(unsigned w) { return __uint_as_float(w << 16); }
__device__ __forceinline__ float bf_hi(unsigned w) { return __uint_as_float(w & 0xffff0000u); }
__device__ __forceinline__ float fast_sigmoid(float x) { return __builtin_amdgcn_rcpf(1.0f + __builtin_amdgcn_exp2f(-1.4426950408889634f * x)); }
__device__ __forceinline__ u32x4 pack8(f32x4 v0, f32x4 v1) { u32x4 w; w.x = cvt_pk_bf16(v0[0], v0[1]); w.y = cvt_pk_bf16(v0[2], v0[3]); w.z = cvt_pk_bf16(v1[0], v1[1]); w.w = cvt_pk_bf16(v1[2], v1[3]); return w; }
__device__ __forceinline__ void unpack8(u32x4 w, f32x4& v0, f32x4& v1) { v0 = (f32x4){bf_lo(w.x), bf_hi(w.x), bf_lo(w.y), bf_hi(w.y)}; v1 = (f32x4){bf_lo(w.z), bf_hi(w.z), bf_lo(w.w), bf_hi(w.w)}; }
__device__ __forceinline__ f32x4 sig4(f32x4 v) { return (f32x4){fast_sigmoid(v[0]), fast_sigmoid(v[1]), fast_sigmoid(v[2]), fast_sigmoid(v[3])}; }

struct EpiProj {
    static constexpr bool PERM = true, AFTER_DRAIN = false;
    bf16_t *Q, *KV, *U, *GA, *GS;
    __device__ __forceinline__ void operator()(const f32x4 (&acc)[2][2][4][2], const Unit& u, int wr, int wc, int fr, int fq) const {
        const int pn = u.pn; bf16_t* base; int ldc, colt, mode;
        if (pn < 2) { base = Q; ldc = 512; colt = pn * 256; mode = 1; }
        else if (pn == 2) { base = KV; ldc = 256; colt = 0; mode = 0; }
        else if (pn < 5) { base = U; ldc = 512; colt = (pn - 3) * 256; mode = 0; }
        else if (pn < 9) { base = GA; ldc = 1024; colt = (pn - 5) * 256; mode = 2; }
        else { base = GS; ldc = 1024; colt = (pn - 9) * 256; mode = 2; }
        const int row0 = u.pm * BM + wr * 64 + fr, col0 = colt + wc * 32 + 8 * fq;
#pragma unroll
        for (int ai = 0; ai < 2; ++ai)
#pragma unroll
            for (int m = 0; m < 4; ++m) { bf16_t* rowp = base + (size_t)(row0 + ai * HALF + m * 16) * ldc + col0;
#pragma unroll
                for (int bj = 0; bj < 2; ++bj) { f32x4 v0 = acc[ai][bj][m][0], v1 = acc[ai][bj][m][1];
                    if (mode == 1) { v0 = v0 * 0.18033688011112042f; v1 = v1 * 0.18033688011112042f; }
                    if (mode == 2) { v0 = sig4(v0); v1 = sig4(v1); }
                    *(u32x4*)(rowp + bj * HALF) = pack8(v0, v1); } }
    }
};
struct EpiGlu {
    static constexpr bool PERM = true, AFTER_DRAIN = false;
    const bf16_t* Z; bf16_t* Z2;
    __device__ __forceinline__ void operator()(const f32x4 (&acc)[2][2][4][2], const Unit& u, int wr, int wc, int fr, int fq) const {
        const int row0 = u.pm * BM + wr * 64 + fr, col0 = u.pn * BM + wc * 32 + 8 * fq;
#pragma unroll
        for (int ai = 0; ai < 2; ++ai)
#pragma unroll
            for (int m = 0; m < 4; ++m) { const size_t off = (size_t)(row0 + ai * HALF + m * 16) * 512 + col0;
#pragma unroll
                for (int bj = 0; bj < 2; ++bj) { f32x4 z0, z1; unpack8(*(const u32x4*)(Z + off + bj * HALF), z0, z1);
                    *(u32x4*)(Z2 + off + bj * HALF) = pack8(z0 * sig4(acc[ai][bj][m][0]), z1 * sig4(acc[ai][bj][m][1])); } }
    }
};
struct EpiGate {
    static constexpr bool PERM = true, AFTER_DRAIN = false;
    const bf16_t* gate; const bf16_t* addend; bf16_t* O;
    __device__ __forceinline__ void operator()(const f32x4 (&acc)[2][2][4][2], const Unit& u, int wr, int wc, int fr, int fq) const {
        const int row0 = u.pm * BM + wr * 64 + fr, col0 = u.pn * BM + wc * 32 + 8 * fq;
#pragma unroll
        for (int ai = 0; ai < 2; ++ai)
#pragma unroll
            for (int m = 0; m < 4; ++m) { const size_t off = (size_t)(row0 + ai * HALF + m * 16) * 1024 + col0;
#pragma unroll
                for (int bj = 0; bj < 2; ++bj) { f32x4 g0, g1; unpack8(*(const u32x4*)(gate + off + bj * HALF), g0, g1);
                    f32x4 v0 = g0 * acc[ai][bj][m][0], v1 = g1 * acc[ai][bj][m][1];
                    if (addend) { f32x4 a0, a1; unpack8(*(const u32x4*)(addend + off + bj * HALF), a0, a1); v0 = v0 + a0; v1 = v1 + a1; }
                    *(u32x4*)(O + off + bj * HALF) = pack8(v0, v1); } }
    }
};
struct EpiF32 {
    static constexpr bool PERM = false, AFTER_DRAIN = false;
    float* C; int ldc;
    __device__ __forceinline__ void operator()(const f32x4 (&acc)[2][2][4][2], const Unit& u, int wr, int wc, int fr, int fq) const {
        const int row0 = u.pm * BM + wr * 64 + fr, col0 = u.pn * BM + wc * 32 + 4 * fq;
#pragma unroll
        for (int ai = 0; ai < 2; ++ai)
#pragma unroll
            for (int m = 0; m < 4; ++m) { float* rowp = C + (size_t)(row0 + ai * HALF + m * 16) * ldc + col0;
#pragma unroll
                for (int bj = 0; bj < 2; ++bj)
#pragma unroll
                    for (int n = 0; n < 2; ++n) *(f32x4*)(rowp + bj * HALF + n * 16) = acc[ai][bj][m][n]; }
    }
};
struct EpiRelu2 {
    static constexpr bool PERM = true, AFTER_DRAIN = false;
    bf16_t* O; int ldc;
    __device__ __forceinline__ void operator()(const f32x4 (&acc)[2][2][4][2], const Unit& u, int wr, int wc, int fr, int fq) const {
        const int row0 = u.pm * BM + wr * 64 + fr, col0 = u.pn * BM + wc * 32 + 8 * fq;
#pragma unroll
        for (int ai = 0; ai < 2; ++ai)
#pragma unroll
            for (int m = 0; m < 4; ++m) { bf16_t* rowp = O + (size_t)(row0 + ai * HALF + m * 16) * ldc + col0;
#pragma unroll
                for (int bj = 0; bj < 2; ++bj) { f32x4 v0 = acc[ai][bj][m][0], v1 = acc[ai][bj][m][1];
#pragma unroll
                    for (int j = 0; j < 4; ++j) { const float a = fmaxf(v0[j], 0.f), b = fmaxf(v1[j], 0.f); v0[j] = a * a; v1[j] = b * b; }
                    *(u32x4*)(rowp + bj * HALF) = pack8(v0, v1); } }
    }
};

template <class Epi, class Sched, bool ALIGN_EPI = false, bool SP2 = false>
__device__ __forceinline__ void gemm_phase(PG8_LAS unsigned char* lds, const Gemm g, const Sched& S, const Epi& E) {
    const int tid = threadIdx.x, wid = __builtin_amdgcn_readfirstlane(tid >> 6), lane = tid & 63, wr = wid >> 2, wc = wid & 3, fr = lane & 15, fq = lane >> 4;
    const int K = g.K, nt = K / BK;
    unsigned voffA[2], voffB[2];
#pragma unroll
    for (int i = 0; i < 2; ++i) { int R, C; stage_rc(tid * 16 + i * 8192, R, C); const int Rb = Epi::PERM ? ((R & ~31) + perm32(R & 31)) : R;
        voffA[i] = (unsigned)(R * K + C) * 2u; voffB[i] = (unsigned)(Rb * K + C) * 2u; }
    const size_t kstep = (size_t)(BK * 2);
    const size_t hstep = (size_t)HALF * K * 2;
    const size_t tstep = 2 * hstep;
    const unsigned ldsw = (unsigned)wid * 1024u;
    const int aoff = lds_byte(wr * 64 + fr, fq * 8), boff = lds_byte(wc * 32 + fr, fq * 8);
#define PG8_SA(b, h) (((b) * 2 + (h)) * HTB)
#define PG8_SB(b, h) ((4 + (b) * 2 + (h)) * HTB)
#define PG8_STAGE(bufoff, gbase, voff) do { _Pragma("unroll") for (int _i = 0; _i < 2; ++_i) \
        __builtin_amdgcn_global_load_lds((const unsigned*)((const char*)(gbase) + (voff)[_i]), (PG8_LAS unsigned*)(lds + (bufoff) + ldsw + _i * 8192), 16, 0, 0); } while (0)
#define PG8_LDA(dst, b, h) do { _Pragma("unroll") for (int m = 0; m < 4; ++m) _Pragma("unroll") for (int k = 0; k < 2; ++k) dst[m][k] = *(const PG8_LAS bf16x8*)(lds + PG8_SA(b, h) + aoff + m * 2048 + k * 1024); } while (0)
#define PG8_LDB(dst, b, h) do { _Pragma("unroll") for (int n = 0; n < 2; ++n) _Pragma("unroll") for (int k = 0; k < 2; ++k) dst[n][k] = *(const PG8_LAS bf16x8*)(lds + PG8_SB(b, h) + boff + n * 2048 + k * 1024); } while (0)
#define PG8_MMA(ai, bj, At, Bt) do { __builtin_amdgcn_s_setprio(1); _Pragma("unroll") for (int m = 0; m < 4; ++m) _Pragma("unroll") for (int n = 0; n < 2; ++n) _Pragma("unroll") for (int k = 0; k < 2; ++k) \
        acc[ai][bj][m][n] = __builtin_amdgcn_mfma_f32_16x16x32_bf16(Bt[n][k], At[m][k], acc[ai][bj][m][n], 0, 0, 0); __builtin_amdgcn_s_setprio(0); } while (0)
#define PG8_WAIT_V(n) asm volatile("s_waitcnt vmcnt(" #n ")" ::: "memory")
#define PG8_WAIT_L(n) asm volatile("s_waitcnt lgkmcnt(" #n ")" ::: "memory")
#define PG8_BAR __builtin_amdgcn_s_barrier()
#define PG8_SCHED __builtin_amdgcn_sched_barrier(0)
    Unit cur, nxt; int ui = 0;
    if (!S.next(0, cur)) return;
    f32x4 acc[2][2][4][2];
#pragma unroll
    for (int a = 0; a < 2; ++a)
#pragma unroll
        for (int b = 0; b < 2; ++b)
#pragma unroll
            for (int m = 0; m < 4; ++m)
#pragma unroll
                for (int n = 0; n < 2; ++n) acc[a][b][m][n] = (f32x4){0.f, 0.f, 0.f, 0.f};
    bf16x8 At[4][2], B0[2][2], B1[2][2];
    const char* cA = (const char*)g.A + (size_t)cur.pm * tstep; const char* cB = (const char*)g.Bt + (size_t)cur.pn * tstep;
    S.a_ready(cur);
    if constexpr (SP2) {
        PG8_STAGE(PG8_SB(0, 0), cB, voffB); PG8_STAGE(PG8_SB(0, 1), cB + hstep, voffB); PG8_STAGE(PG8_SA(0, 0), cA, voffA); PG8_STAGE(PG8_SA(0, 1), cA + hstep, voffA);
        if (wr == 1) PG8_BAR;
        PG8_WAIT_V(2); PG8_BAR;
        PG8_STAGE(PG8_SB(1, 0), cB + kstep, voffB); PG8_STAGE(PG8_SA(1, 0), cA + kstep, voffA); PG8_STAGE(PG8_SB(1, 1), cB + hstep + kstep, voffB);
        PG8_WAIT_V(6); PG8_BAR;
    } else {
        PG8_STAGE(PG8_SB(0, 0), cB, voffB); PG8_STAGE(PG8_SA(0, 0), cA, voffA); PG8_STAGE(PG8_SB(0, 1), cB + hstep, voffB); PG8_STAGE(PG8_SA(0, 1), cA + hstep, voffA);
        if (wr == 1) PG8_BAR;
        PG8_WAIT_V(4); PG8_BAR;
        PG8_STAGE(PG8_SB(1, 0), cB + kstep, voffB); PG8_STAGE(PG8_SA(1, 0), cA + kstep, voffA); PG8_STAGE(PG8_SB(1, 1), cB + hstep + kstep, voffB);
        PG8_WAIT_V(6); PG8_BAR;
    }
    for (;;) {
        const bool has_next = S.next(ui + 1, nxt);
        const char* nA = has_next ? (const char*)g.A + (size_t)nxt.pm * tstep : cA; const char* nB = has_next ? (const char*)g.Bt + (size_t)nxt.pn * tstep : cB;
        for (int t = 0; t < nt; t += 2) {
            const bool last = (t == nt - 2);
            const char* a1 = cA + (size_t)(t + 1) * kstep;
            const char* a2 = last ? nA : cA + (size_t)(t + 2) * kstep; const char* b2 = last ? nB : cB + (size_t)(t + 2) * kstep;
            const char* a3 = a2 + kstep; const char* b3 = b2 + kstep;
            if (last && has_next) S.a_ready(nxt);
            if constexpr (SP2) {
            PG8_LDB(B0, 0, 0); PG8_LDB(B1, 0, 1); PG8_SCHED; PG8_LDA(At, 0, 0); PG8_STAGE(PG8_SA(1, 1), a1 + hstep, voffA);
            PG8_WAIT_V(8); PG8_WAIT_L(0); PG8_BAR; PG8_MMA(0, 0, At, B0); PG8_MMA(0, 1, At, B1); PG8_BAR; PG8_SCHED;
            PG8_LDA(At, 0, 1); PG8_STAGE(PG8_SB(0, 0), b2, voffB); PG8_STAGE(PG8_SB(0, 1), b2 + hstep, voffB); PG8_STAGE(PG8_SA(0, 0), a2, voffA);
            PG8_WAIT_V(8); PG8_WAIT_L(0); PG8_BAR; PG8_MMA(1, 0, At, B0); PG8_MMA(1, 1, At, B1); PG8_BAR; PG8_SCHED;
            PG8_LDB(B0, 1, 0); PG8_LDB(B1, 1, 1); PG8_SCHED; PG8_LDA(At, 1, 0); PG8_STAGE(PG8_SA(0, 1), a2 + hstep, voffA);
            PG8_WAIT_V(8); PG8_WAIT_L(0); PG8_BAR; PG8_MMA(0, 0, At, B0); PG8_MMA(0, 1, At, B1); PG8_BAR; PG8_SCHED;
            PG8_LDA(At, 1, 1); PG8_STAGE(PG8_SB(1, 0), b3, voffB); PG8_STAGE(PG8_SB(1, 1), b3 + hstep, voffB); PG8_STAGE(PG8_SA(1, 0), a3, voffA);
            PG8_WAIT_V(8); PG8_WAIT_L(0); PG8_BAR; PG8_MMA(1, 0, At, B0); PG8_MMA(1, 1, At, B1); PG8_BAR; PG8_SCHED;
            } else {
            PG8_LDB(B0, 0, 0); PG8_SCHED; PG8_LDA(At, 0, 0); PG8_STAGE(PG8_SA(1, 1), a1 + hstep, voffA);
            PG8_WAIT_L(8); PG8_BAR; PG8_WAIT_L(0); PG8_MMA(0, 0, At, B0); PG8_BAR; PG8_SCHED;
            PG8_LDB(B1, 0, 1); PG8_STAGE(PG8_SB(0, 0), b2, voffB);
            PG8_BAR; PG8_WAIT_L(0); PG8_MMA(0, 1, At, B1); PG8_BAR;
            PG8_LDA(At, 0, 1); PG8_STAGE(PG8_SA(0, 0), a2, voffA);
            PG8_BAR; PG8_WAIT_L(0); PG8_MMA(1, 0, At, B0); PG8_BAR; PG8_SCHED;
            PG8_STAGE(PG8_SB(0, 1), b2 + hstep, voffB);
            PG8_WAIT_V(6); PG8_BAR; PG8_MMA(1, 1, At, B1); PG8_BAR;
            PG8_LDB(B0, 1, 0); PG8_SCHED; PG8_LDA(At, 1, 0); PG8_STAGE(PG8_SA(0, 1), a2 + hstep, voffA);
            PG8_WAIT_L(8); PG8_BAR; PG8_WAIT_L(0); PG8_MMA(0, 0, At, B0); PG8_BAR; PG8_SCHED;
            PG8_LDB(B1, 1, 1); PG8_STAGE(PG8_SB(1, 0), b3, voffB);
            PG8_BAR; PG8_WAIT_L(0); PG8_MMA(0, 1, At, B1); PG8_BAR;
            PG8_LDA(At, 1, 1); PG8_STAGE(PG8_SA(1, 0), a3, voffA);
            PG8_BAR; PG8_WAIT_L(0); PG8_MMA(1, 0, At, B0); PG8_BAR; PG8_SCHED;
            PG8_STAGE(PG8_SB(1, 1), b3 + hstep, voffB);
            PG8_WAIT_V(6); PG8_BAR; PG8_MMA(1, 1, At, B1); PG8_BAR;
            }
        }
        if constexpr (ALIGN_EPI) { if (wr == 0) PG8_BAR; }
        if constexpr (!Epi::AFTER_DRAIN) { E(acc, cur, wr, wc, fr, fq); S.done(cur); }
        if (!has_next) break;
#pragma unroll
        for (int a = 0; a < 2; ++a)
#pragma unroll
            for (int b = 0; b < 2; ++b)
#pragma unroll
                for (int m = 0; m < 4; ++m)
#pragma unroll
                    for (int n = 0; n < 2; ++n) acc[a][b][m][n] = (f32x4){0.f, 0.f, 0.f, 0.f};
        cur = nxt; cA = nA; cB = nB; ++ui;
        if constexpr (ALIGN_EPI) { if (wr == 1) PG8_BAR; }
    }
    PG8_WAIT_V(0);
    if constexpr (!ALIGN_EPI) { if (wr == 0) PG8_BAR; }
    PG8_BAR;
    if constexpr (Epi::AFTER_DRAIN) { E.fused(acc, cur, wr, wc, fr, fq, lds, wid, lane); S.done(cur); }
#undef PG8_SA
#undef PG8_SB
#undef PG8_STAGE
#undef PG8_LDA
#undef PG8_LDB
#undef PG8_MMA
#undef PG8_WAIT_V
#undef PG8_WAIT_L
#undef PG8_BAR
#undef PG8_SCHED
}
}
constexpr int NWAVES = 8;
constexpr int NB = 4, SEQ = 4096, M = NB * SEQ, D = 1024, INW = 3328, DFF = 4096;
constexpr int TCH = 64, NCH = SEQ / TCH;
constexpr float RMS_EPS = 1e-6f;
constexpr size_t MiB = 1u << 20;
constexpr size_t WS_CTL = 0, CTL_ZERO_BYTES = 64 * 1024;
constexpr size_t WS_WIN = 1 * MiB, WS_WGLU = 8 * MiB, WS_WAB = 9 * MiB, WS_WSB = 10 * MiB, WS_WOUT = 11 * MiB, WS_WFF1 = 13 * MiB, WS_WFF2 = 21 * MiB;
constexpr size_t WS_XN = 30 * MiB;
constexpr size_t WS_Q = 62 * MiB, WS_KV = 78 * MiB, WS_U = 86 * MiB, WS_GA = 102 * MiB, WS_GS = 134 * MiB, WS_ATT = 166 * MiB, WS_Z = 182 * MiB, WS_Z2 = 198 * MiB, WS_YA = 214 * MiB;
constexpr size_t WS_S = 246 * MiB;
constexpr size_t WS_KTAB = 250 * MiB, WS_PWR = 251 * MiB, WS_PWI = 251 * MiB + 768 * 1024, WS_BBR = 252 * MiB + 512 * 1024, WS_BBI = 252 * MiB + 640 * 1024, WS_BBTR = 252 * MiB + 768 * 1024, WS_BBTI = 252 * MiB + 896 * 1024, WS_T = 253 * MiB;
constexpr size_t WS_E16 = 214 * MiB;
constexpr size_t WS_MG = 62 * MiB;
constexpr size_t WS_O = 102 * MiB;
constexpr size_t WS_F1 = 62 * MiB;
constexpr size_t WS_F2 = 190 * MiB;
constexpr size_t WS_END = 254 * MiB;
constexpr int CW_BAR = 4096;
constexpr int RING_BYTES = 131072, LDSCTL_OFF = RING_BYTES, MISC_OFF = LDSCTL_OFF + 320, LDS_BYTES = 147456;

#define GAS __attribute__((address_space(1)))
#define LAS __attribute__((address_space(3)))
typedef unsigned short bf16;
typedef unsigned v4u __attribute__((ext_vector_type(4)));
typedef float f32x4 __attribute__((ext_vector_type(4)));
__device__ __forceinline__ unsigned f2bf(float f) { unsigned u = __builtin_bit_cast(unsigned, f); return (u + 0x7fffu + ((u >> 16) & 1u)) >> 16; }
__device__ __forceinline__ unsigned pk2(float lo, float hi) { return f2bf(lo) | (f2bf(hi) << 16); }
__device__ __forceinline__ float bf2f(bf16 v) { return __uint_as_float((unsigned)v << 16); }
__device__ __forceinline__ float wave_sum(float v) {
#pragma unroll
    for (int o = 1; o < 64; o <<= 1) v += __shfl_xor(v, o);
    return v;
}
__device__ __forceinline__ float wave_max(float v) {
#pragma unroll
    for (int o = 1; o < 64; o <<= 1) v = fmaxf(v, __shfl_xor(v, o));
    return v;
}
#define XB_TMO      128
#define XB_XCNT(j)  (256  + 64 * (j))
#define XB_XSUB(j)  (1280 + 64 * (j))
#define XB_XGEN(j)  (2304 + 64 * (j))
#define XB_TOP      3328
#define XB_TOPGEN   3392
#define XCD_BAR_WORDS 3456
#define XB_SPIN_CAP (1u << 18)

__device__ __forceinline__ unsigned xb_ld(unsigned* p)              { return __hip_atomic_load(p, __ATOMIC_RELAXED, __HIP_MEMORY_SCOPE_AGENT); }
__device__ __forceinline__ unsigned xb_add(unsigned* p, unsigned v) { return __hip_atomic_fetch_add(p, v, __ATOMIC_RELAXED, __HIP_MEMORY_SCOPE_AGENT); }
__device__ __forceinline__ unsigned xb_xcc_id() { return (unsigned)__builtin_amdgcn_s_getreg((3 << 11) | 20) & 0xFu; }
#define XB_SPIN(cond, bar) do { unsigned _sp = 0; while (cond) { __builtin_amdgcn_s_sleep(1); \
    if ((++_sp & 255u) == 0u) { if (xb_ld(&(bar)[XB_TMO])) break; if (_sp > XB_SPIN_CAP) { atomicAdd(&(bar)[XB_TMO], 1u); break; } } } } while (0)

struct XcdBarrier {
    unsigned* bar; unsigned x;
    volatile LAS unsigned* st;
};

__device__ __forceinline__ XcdBarrier xcd_barrier_post(unsigned* bar, volatile LAS unsigned* st) {
    XcdBarrier b; b.bar = bar; b.x = xb_xcc_id(); b.st = st;
    if (threadIdx.x == 0) (void)xb_add(&bar[XB_XCNT(b.x)], 1u);
    return b;
}
__device__ __forceinline__ void xcd_barrier_complete(unsigned* bar, unsigned x, unsigned& nloc, unsigned& nx) {
    const unsigned G = gridDim.x * gridDim.y * gridDim.z;
    unsigned sum, cnt, mine, sp = 0u;
    for (;;) {
        sum = 0u; cnt = 0u; mine = 0u;
#pragma unroll
        for (unsigned j = 0; j < 16; ++j) { const unsigned c = xb_ld(&bar[XB_XCNT(j)]); sum += c; cnt += (c > 0u) ? 1u : 0u; mine = (j == x) ? c : mine; }
        if (sum == G) break;
        __builtin_amdgcn_s_sleep(1);
        if ((++sp & 255u) == 0u) { if (xb_ld(&bar[XB_TMO])) break; if (sp > XB_SPIN_CAP) { atomicAdd(&bar[XB_TMO], 1u); break; } }
    }
    nloc = mine > 0u ? mine : 1u; nx = cnt > 0u ? cnt : 1u;
}

__device__ __forceinline__ void xcd_barrier(const XcdBarrier& b) {
    asm volatile("s_waitcnt vmcnt(0)" ::: "memory");
    __syncthreads();
    if (threadIdx.x == 0) {
        unsigned* bar = b.bar;
        __builtin_amdgcn_s_waitcnt(0);
        unsigned nloc = b.st[0], nx = b.st[1];
        if (nloc == 0u) { xcd_barrier_complete(bar, b.x, nloc, nx); b.st[0] = nloc; b.st[1] = nx; }
        const unsigned old = xb_add(&bar[XB_XSUB(b.x)], 1u);
        const unsigned gen = old / nloc;
        if (old + 1u == (gen + 1u) * nloc) {
            __builtin_amdgcn_fence(__ATOMIC_RELEASE, "agent");
            asm volatile("s_waitcnt vmcnt(0)" ::: "memory");
            const unsigned og = xb_add(&bar[XB_TOP], 1u);
            const unsigned tg = og / nx;
            if (og + 1u == (tg + 1u) * nx) xb_add(&bar[XB_TOPGEN], 1u);
            else XB_SPIN(xb_ld(&bar[XB_TOPGEN]) == tg, bar);
            __builtin_amdgcn_fence(__ATOMIC_ACQUIRE, "agent");
            xb_add(&bar[XB_XGEN(b.x)], 1u);
            asm volatile("s_waitcnt vmcnt(0)" ::: "memory");
        } else {
            XB_SPIN(xb_ld(&bar[XB_XGEN(b.x)]) == gen, bar);
            __builtin_amdgcn_fence(__ATOMIC_ACQUIRE, "agent");
            asm volatile("s_waitcnt vmcnt(0)" ::: "memory");
        }
    }
    __syncthreads();
}
template <bool HAS_G> __device__ __forceinline__ void p0_transpose_item(const float* W, const float* gk, int K, int N, bf16* WT, LAS float* scr, int item, int lane) {
    const int nblk = N / 32, kb = item / nblk, nb = item % nblk, k0 = 64 * kb, n0 = 32 * nb;
    const int r8 = lane >> 3, c4 = lane & 7;
    f32x4 v[8]; float gv[8];
#pragma unroll
    for (int i = 0; i < 8; ++i) { v[i] = *(const GAS f32x4*)(W + (size_t)(k0 + 8 * i + r8) * N + n0 + 4 * c4); if (HAS_G) gv[i] = gk[k0 + 8 * i + r8]; }
#pragma unroll
    for (int i = 0; i < 8; ++i) { if (HAS_G) v[i] = v[i] * gv[i]; LAS float* d = scr + (8 * i + r8) * 33 + 4 * c4; d[0] = v[i].x; d[1] = v[i].y; d[2] = v[i].z; d[3] = v[i].w; }
    asm volatile("s_waitcnt lgkmcnt(0)" ::: "memory");
    const int c = lane & 7;
#pragma unroll
    for (int j = 0; j < 4; ++j) { const int n = (lane >> 3) + 8 * j; const LAS float* s = scr + (8 * c) * 33 + n;
        v4u o; o.x = pk2(s[0 * 33], s[1 * 33]); o.y = pk2(s[2 * 33], s[3 * 33]); o.z = pk2(s[4 * 33], s[5 * 33]); o.w = pk2(s[6 * 33], s[7 * 33]);
        *(GAS v4u*)(WT + (size_t)(n0 + n) * K + k0 + 8 * c) = o; }
    asm volatile("s_waitcnt lgkmcnt(0)" ::: "memory");
}
__device__ __forceinline__ void rms_row_to_bf16(const float* xrow, bf16* orow, int lane) {
    const GAS f32x4* xr = (const GAS f32x4*)xrow + lane;
    f32x4 v[4]; float s = 0.f;
#pragma unroll
    for (int j = 0; j < 4; ++j) { v[j] = xr[64 * j]; s += (v[j].x * v[j].x + v[j].y * v[j].y) + (v[j].z * v[j].z + v[j].w * v[j].w); }
    const float rstd = 1.f / sqrtf(wave_sum(s) * (1.f / D) + RMS_EPS);
    GAS unsigned long long* o8 = (GAS unsigned long long*)orow + lane;
#pragma unroll
    for (int j = 0; j < 4; ++j) o8[64 * j] = (unsigned long long)pk2(v[j].x * rstd, v[j].y * rstd) | ((unsigned long long)pk2(v[j].z * rstd, v[j].w * rstd) << 32);
}
__device__ __forceinline__ void res_norm_row(const float* orow, const float* xrow, const float* g, float* x1row, bf16* xnrow, int lane) {
    const GAS f32x4* orr = (const GAS f32x4*)orow + lane; const GAS f32x4* xr = (const GAS f32x4*)xrow + lane; const GAS f32x4* gr = (const GAS f32x4*)g + lane;
    f32x4 v[4]; float s = 0.f;
#pragma unroll
    for (int j = 0; j < 4; ++j) { v[j] = orr[64 * j]; s += (v[j].x * v[j].x + v[j].y * v[j].y) + (v[j].z * v[j].z + v[j].w * v[j].w); }
    const float rstd = 1.f / sqrtf(wave_sum(s) * (1.f / D) + RMS_EPS);
    float s2 = 0.f;
#pragma unroll
    for (int j = 0; j < 4; ++j) { v[j] = xr[64 * j] + v[j] * rstd * gr[64 * j]; s2 += (v[j].x * v[j].x + v[j].y * v[j].y) + (v[j].z * v[j].z + v[j].w * v[j].w); }
    GAS f32x4* x1 = (GAS f32x4*)x1row + lane;
#pragma unroll
    for (int j = 0; j < 4; ++j) x1[64 * j] = v[j];
    if (xnrow) {
        const float rstd2 = 1.f / sqrtf(wave_sum(s2) * (1.f / D) + RMS_EPS);
        GAS unsigned long long* o8 = (GAS unsigned long long*)xnrow + lane;
#pragma unroll
        for (int j = 0; j < 4; ++j) o8[64 * j] = (unsigned long long)pk2(v[j].x * rstd2, v[j].y * rstd2) | ((unsigned long long)pk2(v[j].z * rstd2, v[j].w * rstd2) << 32);
    }
}

__device__ __forceinline__ int t5_bucket(int dist) {
    if (dist < 16) return dist;
    const int large = 16 + (int)(logf((float)dist / 16.0f) / logf(8.0f) * 16.0f);
    return large < 31 ? large : 31;
}
__device__ __forceinline__ void unpack8f(v4u w, float (&f)[8]) {
    f[0] = __uint_as_float(w.x << 16); f[1] = __uint_as_float(w.x & 0xffff0000u); f[2] = __uint_as_float(w.y << 16); f[3] = __uint_as_float(w.y & 0xffff0000u);
    f[4] = __uint_as_float(w.z << 16); f[5] = __uint_as_float(w.z & 0xffff0000u); f[6] = __uint_as_float(w.w << 16); f[7] = __uint_as_float(w.w & 0xffff0000u);
}
__device__ __forceinline__ void attn_simple_phase(const bf16* Q, const bf16* KV, bf16* ATT, const float* rel_bias, const float* sinks, int gw, int NGW, int lane) {
    const int bk0 = t5_bucket(lane), bk1 = t5_bucket(lane + 64);
    for (int unit = gw; unit < M * 8; unit += NGW) {
        const int m = unit >> 3, h = unit & 7, kvh = h >> 2, t = m & (SEQ - 1);
        const float qv = bf2f(Q[(size_t)m * 512 + h * 64 + lane]);
        const bool ok0 = (t - lane) >= 0, ok1 = (t - lane - 64) >= 0;
        const bf16* k0p = KV + (size_t)(m - (ok0 ? lane : 0)) * 256 + kvh * 64;
        const bf16* k1p = KV + (size_t)(m - (ok1 ? lane + 64 : 0)) * 256 + kvh * 64;
        float s0 = 0.f, s1 = 0.f;
#pragma unroll
        for (int d8 = 0; d8 < 8; ++d8) {
            float ka[8], kb[8]; unpack8f(*(const GAS v4u*)(k0p + d8 * 8), ka); unpack8f(*(const GAS v4u*)(k1p + d8 * 8), kb);
#pragma unroll
            for (int j = 0; j < 8; ++j) { const float qd = __shfl(qv, d8 * 8 + j); s0 += qd * ka[j]; s1 += qd * kb[j]; }
        }
        const float l0 = ok0 ? s0 + rel_bias[bk0 * 8 + h] : -1e30f, l1 = ok1 ? s1 + rel_bias[bk1 * 8 + h] : -1e30f;
        const float sink = sinks[h];
        const float mx = fmaxf(wave_max(fmaxf(l0, l1)), sink);
        float p0 = expf(l0 - mx), p1 = expf(l1 - mx);
        const float den = wave_sum(p0 + p1) + expf(sink - mx);
        p0 /= den; p1 /= den;
        float o = 0.f;
        const int nk = (t + 1) < 128 ? (t + 1) : 128;
        for (int dist = 0; dist < nk; ++dist) { const float pd = __shfl(dist < 64 ? p0 : p1, dist & 63); o += pd * bf2f(KV[(size_t)(m - dist) * 256 + 128 + kvh * 64 + lane]); }
        ATT[(size_t)m * 512 + h * 64 + lane] = (bf16)f2bf(o);
    }
}

__device__ __forceinline__ float gelu_tanh(float y) { return 0.5f * y * (1.0f + tanhf(0.7978845608028654f * (y + 0.044715f * y * y * y))); }
__device__ __forceinline__ void ssm_consts(int g, int p, const float* lam_re, const float* lam_im, const float* log_dt, const float* b_re, const float* b_im,
                                           float& abr, float& abi, float (&bbr)[16], float (&bbi)[16]) {
    const float dt = expf(log_dt[g]);
    const float lr = lam_re[g * 64 + p], li = lam_im[g * 64 + p];
    const float mag = expf(lr * dt);
    abr = mag * cosf(li * dt); abi = mag * sinf(li * dt);
    const float nr = abr - 1.0f, den = lr * lr + li * li;
    const float fr = (nr * lr + abi * li) / den, fi = (abi * lr - nr * li) / den;
#pragma unroll
    for (int c = 0; c < 16; ++c) { const float br = b_re[(size_t)(g * 64 + p) * 16 + c], bi = b_im[(size_t)(g * 64 + p) * 16 + c]; bbr[c] = fr * br - fi * bi; bbi[c] = fr * bi + fi * br; }
}
__device__ __forceinline__ void load_u16(const bf16* up, float (&uv)[16]) {
    float a[8], b[8]; unpack8f(*(const GAS v4u*)up, a); unpack8f(*(const GAS v4u*)(up + 8), b);
#pragma unroll
    for (int c = 0; c < 8; ++c) { uv[c] = a[c]; uv[8 + c] = b[c]; }
}
__device__ __forceinline__ void ssm_state_phase(const bf16* U, float* S, const float* lam_re, const float* lam_im, const float* log_dt, const float* b_re, const float* b_im, int gw, int NGW, int lane) {
    for (int unit = gw; unit < NB * NCH * 32; unit += NGW) {
        const int g = unit & 31, j = (unit >> 5) & (NCH - 1), b = unit >> 11;
        float abr, abi, bbr[16], bbi[16];
        ssm_consts(g, lane, lam_re, lam_im, log_dt, b_re, b_im, abr, abi, bbr, bbi);
        float hr = 0.f, hi = 0.f;
        const bf16* up = U + (size_t)(b * SEQ + j * TCH) * 512 + g * 16;
        for (int s = 0; s < TCH; ++s) {
            float uv[16]; load_u16(up + (size_t)s * 512, uv);
            float bur = 0.f, bui = 0.f;
#pragma unroll
            for (int c = 0; c < 16; ++c) { bur += bbr[c] * uv[c]; bui += bbi[c] * uv[c]; }
            const float nr = abr * hr - abi * hi + bur, ni = abr * hi + abi * hr + bui; hr = nr; hi = ni;
        }
        float* sp = S + ((size_t)(b * NCH + j) * 32 + g) * 128;
        sp[lane] = hr; sp[64 + lane] = hi;
    }
}
__device__ __forceinline__ void ssm_out_phase(const bf16* U, const float* S, bf16* Z, const float* lam_re, const float* lam_im, const float* log_dt, const float* b_re, const float* b_im,
                                              const float* c_re, const float* c_im, const float* d_skip, int gw, int NGW, int lane) {
    for (int unit = gw; unit < NB * NCH * 32; unit += NGW) {
        const int g = unit & 31, j = (unit >> 5) & (NCH - 1), b = unit >> 11;
        float abr, abi, bbr[16], bbi[16], cr[16], ci[16];
        ssm_consts(g, lane, lam_re, lam_im, log_dt, b_re, b_im, abr, abi, bbr, bbi);
#pragma unroll
        for (int c = 0; c < 16; ++c) { cr[c] = c_re[(size_t)(g * 16 + c) * 64 + lane]; ci[c] = c_im[(size_t)(g * 16 + c) * 64 + lane]; }
        const float dsk = d_skip[g * 16 + (lane & 15)];
        float aTr = abr, aTi = abi;
#pragma unroll
        for (int q = 0; q < 6; ++q) { const float r2 = aTr * aTr - aTi * aTi, i2 = 2.f * aTr * aTi; aTr = r2; aTi = i2; }
        float hr = 0.f, hi = 0.f;
        const float* sp = S + ((size_t)(b * NCH) * 32 + g) * 128 + lane;
        for (int m2 = 0; m2 < j; ++m2) { const float sr = sp[(size_t)m2 * 4096], si = sp[(size_t)m2 * 4096 + 64]; const float nr = aTr * hr - aTi * hi + sr, ni = aTr * hi + aTi * hr + si; hr = nr; hi = ni; }
        const bf16* up = U + (size_t)(b * SEQ + j * TCH) * 512 + g * 16;
        bf16* zp = Z + (size_t)(b * SEQ + j * TCH) * 512 + g * 16;
        for (int s = 0; s < TCH; ++s) {
            float uv[16]; load_u16(up + (size_t)s * 512, uv);
            float bur = 0.f, bui = 0.f, umine = 0.f;
#pragma unroll
            for (int c = 0; c < 16; ++c) { bur += bbr[c] * uv[c]; bui += bbi[c] * uv[c]; umine = ((lane & 15) == c) ? uv[c] : umine; }
            const float nr = abr * hr - abi * hi + bur, ni = abr * hi + abi * hr + bui; hr = nr; hi = ni;
            float ymine = 0.f;
#pragma unroll
            for (int c = 0; c < 16; ++c) { const float y = wave_sum(cr[c] * hr - ci[c] * hi); ymine = (lane == c) ? y : ymine; }
            if (lane < 16) zp[(size_t)s * 512 + lane] = (bf16)f2bf(gelu_tanh(ymine + dsk * umine));
        }
    }
}
typedef short bf16x8v __attribute__((ext_vector_type(8)));
typedef float f32x2_t __attribute__((ext_vector_type(2))); typedef __bf16 bf16x2_t __attribute__((ext_vector_type(2)));
__device__ __forceinline__ unsigned cvtpk(float lo, float hi) { f32x2_t v = {lo, hi}; bf16x2_t b = __builtin_convertvector(v, bf16x2_t); return __builtin_bit_cast(unsigned, b); }
__device__ __forceinline__ bf16x8v pack8v(const float (&f)[8]) { v4u w; w.x = cvtpk(f[0], f[1]); w.y = cvtpk(f[2], f[3]); w.z = cvtpk(f[4], f[5]); w.w = cvtpk(f[6], f[7]); return __builtin_bit_cast(bf16x8v, w); }
constexpr float LOG2E = 1.4426950408889634f;

constexpr int PWS = 68;
__device__ __forceinline__ void ssm_pw_unit(int g, int row, int p, const float* lam_re, const float* lam_im, const float* log_dt, float* PWr, float* PWi) {
    const float dt = expf(log_dt[g]);
    const float lr = lam_re[g * 64 + p], li = lam_im[g * 64 + p];
    const float mag = expf(lr * dt);
    double br = (double)(mag * cosf(li * dt)), bi = (double)(mag * sinf(li * dt));
    int e = row <= 64 ? row : 128 + 64 * (row - 65);
    double rr = 1.0, ri = 0.0;
    for (int bit = 0; bit < 9; ++bit) {
        if (e & 1) { const double nr = rr * br - ri * bi, ni = rr * bi + ri * br; rr = nr; ri = ni; }
        const double sr = br * br - bi * bi, si = 2.0 * br * bi; br = sr; bi = si; e >>= 1;
    }
    PWr[(size_t)(g * PWS + row) * 64 + p] = (float)rr; PWi[(size_t)(g * PWS + row) * 64 + p] = (float)ri;
}
__device__ __forceinline__ void ssm_bb_unit(int g, int p, const float* lam_re, const float* lam_im, const float* log_dt, const float* b_re, const float* b_im, float* BBr, float* BBi, float* BBtr, float* BBti) {
    float abr, abi, bbr[16], bbi[16];
    ssm_consts(g, p, lam_re, lam_im, log_dt, b_re, b_im, abr, abi, bbr, bbi);
#pragma unroll
    for (int c = 0; c < 16; ++c) { BBr[(size_t)(g * 64 + p) * 16 + c] = bbr[c]; BBi[(size_t)(g * 64 + p) * 16 + c] = bbi[c]; BBtr[(size_t)(g * 16 + c) * 64 + p] = bbr[c]; BBti[(size_t)(g * 16 + c) * 64 + p] = bbi[c]; }
}
__device__ __forceinline__ void ssm_ktab_phase(const float* PWr, const float* PWi, const float* BBtr, const float* BBti, const float* c_re, const float* c_im, bf16* Ktab, int gw, int NGW, int lane) {
    const int l15 = lane & 15, lq = lane >> 4;
    for (int unit = gw; unit < 32 * 8; unit += NGW) {
        const int g = unit >> 3, t8 = (unit & 7) * 8;
        bf16x8v Cf[4]; float br[2][8], bi[2][8];
#pragma unroll
        for (int ks = 0; ks < 2; ++ks) {
            const size_t oc = (size_t)(g * 16 + l15) * 64 + 32 * ks + 8 * lq;
            const f32x4 c0 = *(const GAS f32x4*)(c_re + oc), c1 = *(const GAS f32x4*)(c_re + oc + 4), d0 = *(const GAS f32x4*)(c_im + oc), d1 = *(const GAS f32x4*)(c_im + oc + 4);
            const f32x4 e0 = *(const GAS f32x4*)(BBtr + oc), e1 = *(const GAS f32x4*)(BBtr + oc + 4), f0 = *(const GAS f32x4*)(BBti + oc), f1 = *(const GAS f32x4*)(BBti + oc + 4);
            float t[8], u[8];
#pragma unroll
            for (int j = 0; j < 4; ++j) { t[j] = c0[j]; t[4 + j] = c1[j]; u[j] = -d0[j]; u[4 + j] = -d1[j]; br[ks][j] = e0[j]; br[ks][4 + j] = e1[j]; bi[ks][j] = f0[j]; bi[ks][4 + j] = f1[j]; }
            Cf[ks] = pack8v(t); Cf[ks + 2] = pack8v(u);
        }
#pragma unroll 2
        for (int tt = 0; tt < 8; ++tt) {
            const int tau = t8 + tt;
            f32x4 acc = (f32x4){0.f, 0.f, 0.f, 0.f};
#pragma unroll
            for (int ks = 0; ks < 2; ++ks) {
                const size_t o = (size_t)(g * PWS + tau) * 64 + 32 * ks + 8 * lq;
                const f32x4 r0 = *(const GAS f32x4*)(PWr + o), r1 = *(const GAS f32x4*)(PWr + o + 4), i0 = *(const GAS f32x4*)(PWi + o), i1 = *(const GAS f32x4*)(PWi + o + 4);
                float xr[8], xi[8];
#pragma unroll
                for (int j = 0; j < 4; ++j) {
                    xr[j] = r0[j] * br[ks][j] - i0[j] * bi[ks][j]; xi[j] = r0[j] * bi[ks][j] + i0[j] * br[ks][j];
                    xr[4 + j] = r1[j] * br[ks][4 + j] - i1[j] * bi[ks][4 + j]; xi[4 + j] = r1[j] * bi[ks][4 + j] + i1[j] * br[ks][4 + j]; }
                acc = __builtin_amdgcn_mfma_f32_16x16x32_bf16(pack8v(xr), Cf[ks], acc, 0, 0, 0);
                acc = __builtin_amdgcn_mfma_f32_16x16x32_bf16(pack8v(xi), Cf[ks + 2], acc, 0, 0, 0);
            }
            *(GAS unsigned long long*)(Ktab + ((size_t)(g * 64 + tau) * 16 + l15) * 16 + 4 * lq) = (unsigned long long)cvtpk(acc[0], acc[1]) | ((unsigned long long)cvtpk(acc[2], acc[3]) << 32);
        }
    }
}
__device__ __forceinline__ void ssm_e16_phase(const float* PWr, const float* PWi, const float* BBr, const float* BBi, bf16* E16, int gw, int NGW, int lane) {
    for (int unit = gw; unit < 32 * 64; unit += NGW) {
        const int g = unit >> 6, p = unit & 63, s2 = lane >> 2, c0 = (lane & 3) * 4;
        const float pr = PWr[(size_t)(g * PWS + 15 - s2) * 64 + p], pi = PWi[(size_t)(g * PWS + 15 - s2) * 64 + p];
        const f32x4 br = *(const GAS f32x4*)(BBr + (size_t)(g * 64 + p) * 16 + c0), bi = *(const GAS f32x4*)(BBi + (size_t)(g * 64 + p) * 16 + c0);
        const f32x4 xr = pr * br - pi * bi, xi = pr * bi + pi * br;
        *(GAS unsigned long long*)(E16 + (size_t)(g * 128 + p) * 256 + lane * 4) = (unsigned long long)cvtpk(xr[0], xr[1]) | ((unsigned long long)cvtpk(xr[2], xr[3]) << 32);
        *(GAS unsigned long long*)(E16 + (size_t)(g * 128 + 64 + p) * 256 + lane * 4) = (unsigned long long)cvtpk(xi[0], xi[1]) | ((unsigned long long)cvtpk(xi[2], xi[3]) << 32);
    }
}
__device__ __forceinline__ void ssm_s_phase(LAS unsigned char* L3, const bf16* U, float* S, float* T, const bf16* E16, const float* PWr, const float* PWi, int G, int vcu, int tid, int lane, int wave) {
    const int l15 = lane & 15, lq = lane >> 4;
    for (int bu = vcu; bu < 256; bu += G) {
        const int g = bu >> 3, sp = (bu & 7) * 8 + wave, b = sp >> 4, si = sp & 15;
        const size_t rowb = (size_t)b * SEQ + (size_t)si * 256;
        bf16x8v Af[8];
#pragma unroll
        for (int ks = 0; ks < 8; ++ks) Af[ks] = *(const GAS bf16x8v*)(U + (rowb + 16 * l15 + 2 * ks + (lq >> 1)) * 512 + g * 16 + 8 * (lq & 1));
        __syncthreads();
        for (int i = tid; i < 4096; i += 512) { const int q = i >> 5, ch = i & 31; *(LAS v4u*)(L3 + q * 528 + ch * 16) = *(const GAS v4u*)(E16 + (size_t)(g * 128 + q) * 256 + ch * 8); }
        __syncthreads();
        f32x4 acc[8];
#pragma unroll
        for (int nt = 0; nt < 8; ++nt) acc[nt] = (f32x4){0.f, 0.f, 0.f, 0.f};
#pragma unroll
        for (int ks = 0; ks < 8; ++ks)
#pragma unroll
            for (int nt = 0; nt < 8; ++nt)
                acc[nt] = __builtin_amdgcn_mfma_f32_16x16x32_bf16(Af[ks], *(const LAS bf16x8v*)(L3 + (16 * nt + l15) * 528 + (32 * ks + 8 * lq) * 2), acc[nt], 0, 0, 0);
        const int wrow = lq == 0 ? 66 : (lq == 1 ? 65 : (lq == 2 ? 64 : 0));
#pragma unroll
        for (int nt = 0; nt < 4; ++nt) {
            const int p = 16 * nt + l15;
            float sr = acc[nt][3], sim = acc[nt + 4][3];
#pragma unroll
            for (int rr = 0; rr < 3; ++rr) { const float wr = PWr[(size_t)(g * PWS + 16 * (3 - rr)) * 64 + p], wi = PWi[(size_t)(g * PWS + 16 * (3 - rr)) * 64 + p];
                sr += wr * acc[nt][rr] - wi * acc[nt + 4][rr]; sim += wr * acc[nt + 4][rr] + wi * acc[nt][rr]; }
            float* so = S + ((size_t)(b * NCH + si * 4 + lq) * 32 + g) * 128 + p;
            so[0] = sr; so[64] = sim;
            const float vr = PWr[(size_t)(g * PWS + wrow) * 64 + p], vi = PWi[(size_t)(g * PWS + wrow) * 64 + p];
            float tr = vr * sr - vi * sim, ti = vr * sim + vi * sr;
            tr += __shfl_xor(tr, 16); tr += __shfl_xor(tr, 32); ti += __shfl_xor(ti, 16); ti += __shfl_xor(ti, 32);
            if (lq == 0) { float* to = T + ((size_t)(b * 16 + si) * 32 + g) * 128 + p; to[0] = tr; to[64] = ti; }
        }
    }
}
template <int SEG> __device__ __forceinline__ void conv_seg(LAS unsigned char* L3, LAS unsigned char* ub, f32x4 (&acc)[4], int l15, int lh, int lo) {
#pragma unroll 2
    for (int t2 = 8 * SEG; t2 < 8 * SEG + 8; ++t2) {
        const int tau0 = 2 * t2;
        const bf16x8v Kf = *(const LAS bf16x8v*)(L3 + (tau0 + lh) * 512 + l15 * 32 + lo * 16);
#pragma unroll
        for (int i = SEG; i < 4; ++i) {
            const bf16x8v Yf = *(const LAS bf16x8v*)(ub + (64 + 16 * i - tau0 + l15 - lh) * 32 + lo * 16);
            acc[i] = __builtin_amdgcn_mfma_f32_16x16x32_bf16(Kf, Yf, acc[i], 0, 0, 0);
        }
    }
}
__device__ __forceinline__ void ssm_y_phase(LAS unsigned char* L3, const bf16* U, const float* S, const float* T, bf16* Z, const bf16* Ktab, const float* PWr, const float* PWi,
                                            const float* c_re, const float* c_im, const float* d_skip, int G, int vcu, int tid, int lane, int wave) {
    const int l15 = lane & 15, lq = lane >> 4, lh = lane >> 5, lo = (lane >> 4) & 1;
    LAS unsigned char* ub = L3 + 32768 + wave * 6144; LAS float* hb = (LAS float*)(ub + 4096);
    for (int bu = vcu; bu < 256; bu += G) {
        const int g = bu >> 3, b = (bu >> 1) & 3, hf = bu & 1;
        __syncthreads();
        for (int i = tid; i < 2048; i += 512) *(LAS v4u*)(L3 + i * 16) = *(const GAS v4u*)(Ktab + (size_t)g * 16384 + i * 8);
        *(LAS v4u*)(ub + lane * 16) = (v4u){0u, 0u, 0u, 0u}; *(LAS v4u*)(ub + 1024 + lane * 16) = (v4u){0u, 0u, 0u, 0u};
        __syncthreads();
        const float a16r = PWr[(size_t)(g * PWS + 16) * 64 + lane], a16i = PWi[(size_t)(g * PWS + 16) * 64 + lane];
        const float aTr = PWr[(size_t)(g * PWS + 64) * 64 + lane], aTi = PWi[(size_t)(g * PWS + 64) * 64 + lane];
        float pwr[2][8], pwi[2][8]; bf16x8v Cf[4];
#pragma unroll
        for (int ks = 0; ks < 2; ++ks) {
            const size_t o = (size_t)(g * PWS + l15 + 1) * 64 + 32 * ks + 8 * lq;
            const f32x4 r0 = *(const GAS f32x4*)(PWr + o), r1 = *(const GAS f32x4*)(PWr + o + 4), i0 = *(const GAS f32x4*)(PWi + o), i1 = *(const GAS f32x4*)(PWi + o + 4);
#pragma unroll
            for (int j = 0; j < 4; ++j) { pwr[ks][j] = r0[j]; pwr[ks][4 + j] = r1[j]; pwi[ks][j] = i0[j]; pwi[ks][4 + j] = i1[j]; }
            const size_t oc = (size_t)(g * 16 + l15) * 64 + 32 * ks + 8 * lq;
            const f32x4 c0 = *(const GAS f32x4*)(c_re + oc), c1 = *(const GAS f32x4*)(c_re + oc + 4), d0 = *(const GAS f32x4*)(c_im + oc), d1 = *(const GAS f32x4*)(c_im + oc + 4);
            float t[8], s[8];
#pragma unroll
            for (int j = 0; j < 4; ++j) { t[j] = c0[j]; t[4 + j] = c1[j]; s[j] = -d0[j]; s[4 + j] = -d1[j]; }
            Cf[ks] = pack8v(t); Cf[ks + 2] = pack8v(s);
        }
        float dsk[4];
#pragma unroll
        for (int r = 0; r < 4; ++r) dsk[r] = d_skip[g * 16 + 4 * lq + r];
        const int j0 = hf * 32 + wave * 4, si = j0 >> 2;
        float Hr = 0.f, Hi = 0.f;
        { const float a2r = PWr[(size_t)(g * PWS + 67) * 64 + lane], a2i = PWi[(size_t)(g * PWS + 67) * 64 + lane];
          const float* tp = T + ((size_t)(b * 16) * 32 + g) * 128 + lane;
          float tr[15], ti[15];
#pragma unroll
          for (int q = 0; q < 15; ++q) { const bool on = q < si; tr[q] = on ? tp[(size_t)q * 4096] : 0.f; ti[q] = on ? tp[(size_t)q * 4096 + 64] : 0.f; }
#pragma unroll
          for (int q = 0; q < 15; ++q) if (q < si) { const float nr = a2r * Hr - a2i * Hi + tr[q], ni = a2r * Hi + a2i * Hr + ti[q]; Hr = nr; Hi = ni; } }
        for (int jj = 0; jj < 4; ++jj) {
            const int j = j0 + jj; const size_t row0 = (size_t)b * SEQ + (size_t)j * TCH;
            { const bf16* up = U + (row0 + lane) * 512 + g * 16; const v4u u0 = *(const GAS v4u*)up, u1 = *(const GAS v4u*)(up + 8);
              *(LAS v4u*)(ub + (64 + lane) * 32) = u0; *(LAS v4u*)(ub + (64 + lane) * 32 + 16) = u1; }
            { float xr = Hr, xi = Hi;
#pragma unroll
              for (int i = 0; i < 4; ++i) { hb[i * 128 + lane] = xr; hb[i * 128 + 64 + lane] = xi; const float nr = a16r * xr - a16i * xi, ni = a16r * xi + a16i * xr; xr = nr; xi = ni; } }
            const float snr = S[((size_t)(b * NCH + j) * 32 + g) * 128 + lane], sni = S[((size_t)(b * NCH + j) * 32 + g) * 128 + 64 + lane];
            asm volatile("s_waitcnt lgkmcnt(0)" ::: "memory");
            f32x4 acc[4];
#pragma unroll
            for (int i = 0; i < 4; ++i) acc[i] = (f32x4){0.f, 0.f, 0.f, 0.f};
            conv_seg<0>(L3, ub, acc, l15, lh, lo); conv_seg<1>(L3, ub, acc, l15, lh, lo); conv_seg<2>(L3, ub, acc, l15, lh, lo); conv_seg<3>(L3, ub, acc, l15, lh, lo);
#pragma unroll
            for (int i = 0; i < 4; ++i)
#pragma unroll
                for (int ks = 0; ks < 2; ++ks) {
                    const LAS float* hp = hb + i * 128 + 32 * ks + 8 * lq;
                    const f32x4 h0 = *(const LAS f32x4*)hp, h1 = *(const LAS f32x4*)(hp + 4), g0 = *(const LAS f32x4*)(hp + 64), g1 = *(const LAS f32x4*)(hp + 68);
                    float re[8], im[8];
#pragma unroll
                    for (int q = 0; q < 4; ++q) {
                        re[q] = pwr[ks][q] * h0[q] - pwi[ks][q] * g0[q]; im[q] = pwr[ks][q] * g0[q] + pwi[ks][q] * h0[q];
                        re[4 + q] = pwr[ks][4 + q] * h1[q] - pwi[ks][4 + q] * g1[q]; im[4 + q] = pwr[ks][4 + q] * g1[q] + pwi[ks][4 + q] * h1[q]; }
                    acc[i] = __builtin_amdgcn_mfma_f32_16x16x32_bf16(Cf[ks], pack8v(re), acc[i], 0, 0, 0);
                    acc[i] = __builtin_amdgcn_mfma_f32_16x16x32_bf16(Cf[ks + 2], pack8v(im), acc[i], 0, 0, 0);
                }
#pragma unroll
            for (int i = 0; i < 4; ++i) {
                const int t = 16 * i + l15;
                const unsigned long long uw = *(const LAS unsigned long long*)(ub + (64 + t) * 32 + lq * 8);
                const unsigned w0 = (unsigned)uw, w1 = (unsigned)(uw >> 32);
                const float y0 = gelu_tanh(acc[i][0] + dsk[0] * __uint_as_float(w0 << 16)), y1 = gelu_tanh(acc[i][1] + dsk[1] * __uint_as_float(w0 & 0xffff0000u));
                const float y2 = gelu_tanh(acc[i][2] + dsk[2] * __uint_as_float(w1 << 16)), y3 = gelu_tanh(acc[i][3] + dsk[3] * __uint_as_float(w1 & 0xffff0000u));
                *(GAS unsigned long long*)(Z + (row0 + t) * 512 + g * 16 + 4 * lq) = (unsigned long long)cvtpk(y0, y1) | ((unsigned long long)cvtpk(y2, y3) << 32);
            }
            asm volatile("s_waitcnt lgkmcnt(0)" ::: "memory");
            { const float nr = aTr * Hr - aTi * Hi + snr, ni = aTr * Hi + aTi * Hr + sni; Hr = nr; Hi = ni; }
        }
    }
}
constexpr int AT_KB = 0, AT_VT = 36864;
__device__ __forceinline__ void attn_mfma_phase(LAS unsigned char* L3, const bf16* Q, const bf16* KV, bf16* ATT, const float* rel_bias, const float* sinks, int G, int vcu, int tid, int lane, int wave) {
    const int l15 = lane & 15, lq = lane >> 4, hq = wave >> 1, half = wave & 1;
    for (int bu = vcu; bu < 256; bu += G) {
        const int kvh = bu & 1, nb = (bu >> 1) & 31, b = bu >> 6, h = kvh * 4 + hq;
        const size_t rowc = (size_t)b * SEQ + (size_t)nb * 128;
        __syncthreads();
        for (int i = tid; i < 2048; i += 512) { const int key = i >> 3, ch = i & 7; v4u v = (v4u){0u, 0u, 0u, 0u};
            if (nb > 0 || key >= 128) v = *(const GAS v4u*)(KV + (rowc + key - 128) * 256 + kvh * 64 + ch * 8);
            *(LAS v4u*)(L3 + AT_KB + key * 144 + ch * 16) = v; }
        for (int i = tid; i < 2048; i += 512) { const int key = i & 255, ch = i >> 8; v4u v = (v4u){0u, 0u, 0u, 0u};
            if (nb > 0 || key >= 128) v = *(const GAS v4u*)(KV + (rowc + key - 128) * 256 + 128 + kvh * 64 + ch * 8);
            LAS bf16* vt = (LAS bf16*)(L3 + AT_VT) + (ch * 8) * 264 + key;
            vt[0 * 264] = (bf16)(v.x & 0xffffu); vt[1 * 264] = (bf16)(v.x >> 16); vt[2 * 264] = (bf16)(v.y & 0xffffu); vt[3 * 264] = (bf16)(v.y >> 16);
            vt[4 * 264] = (bf16)(v.z & 0xffffu); vt[5 * 264] = (bf16)(v.z >> 16); vt[6 * 264] = (bf16)(v.w & 0xffffu); vt[7 * 264] = (bf16)(v.w >> 16); }
        __syncthreads();
        float bias[9][4];
#pragma unroll
        for (int dk = 0; dk < 9; ++dk)
#pragma unroll
            for (int r = 0; r < 4; ++r) { const int dist = 128 + l15 - 4 * lq - 16 * dk - r; bias[dk][r] = (dist >= 0 && dist < 128) ? rel_bias[t5_bucket(dist) * 8 + h] * LOG2E : -1e30f; }
        const float sinkv = sinks[h] * LOG2E;
#pragma unroll 1
        for (int qt = 0; qt < 4; ++qt) {
            const size_t qrow = rowc + 64 * half + 16 * qt + l15;
            const bf16x8v Qf0 = *(const GAS bf16x8v*)(Q + qrow * 512 + h * 64 + 8 * lq), Qf1 = *(const GAS bf16x8v*)(Q + qrow * 512 + h * 64 + 32 + 8 * lq);
            f32x4 sc[9]; float mx = -1e30f;
#pragma unroll
            for (int dk = 0; dk < 9; ++dk) {
                const int kj0 = 64 * half + 16 * (qt + dk);
                const LAS unsigned char* kp = L3 + AT_KB + (kj0 + l15) * 144 + lq * 16;
                f32x4 a = (f32x4){0.f, 0.f, 0.f, 0.f};
                a = __builtin_amdgcn_mfma_f32_16x16x32_bf16(*(const LAS bf16x8v*)kp, Qf0, a, 0, 0, 0);
                a = __builtin_amdgcn_mfma_f32_16x16x32_bf16(*(const LAS bf16x8v*)(kp + 64), Qf1, a, 0, 0, 0);
#pragma unroll
                for (int r = 0; r < 4; ++r) { float s = a[r] + bias[dk][r]; if (nb == 0 && kj0 + 4 * lq + r < 128) s = -1e30f; a[r] = s; mx = fmaxf(mx, s); }
                sc[dk] = a;
            }
            mx = fmaxf(mx, __shfl_xor(mx, 16)); mx = fmaxf(mx, __shfl_xor(mx, 32)); mx = fmaxf(mx, sinkv);
            float sum = 0.f;
#pragma unroll
            for (int dk = 0; dk < 9; ++dk)
#pragma unroll
                for (int r = 0; r < 4; ++r) { const float p = __builtin_amdgcn_exp2f(sc[dk][r] - mx); sc[dk][r] = p; sum += p; }
            sum += __shfl_xor(sum, 16); sum += __shfl_xor(sum, 32); sum += __builtin_amdgcn_exp2f(sinkv - mx);
            f32x4 o[4];
#pragma unroll
            for (int dt = 0; dt < 4; ++dt) o[dt] = (f32x4){0.f, 0.f, 0.f, 0.f};
#pragma unroll
            for (int pr = 0; pr < 5; ++pr) {
                float pf[8];
#pragma unroll
                for (int r = 0; r < 4; ++r) { pf[r] = sc[2 * pr][r]; pf[4 + r] = (pr < 4) ? sc[(pr < 4) ? 2 * pr + 1 : 0][r] : 0.f; }
                const bf16x8v Pf = pack8v(pf);
                const int keyA = 64 * half + 16 * (qt + 2 * pr) + 4 * lq;
#pragma unroll
                for (int dt = 0; dt < 4; ++dt) {
                    const LAS bf16* vp = (const LAS bf16*)(L3 + AT_VT) + (16 * dt + l15) * 264 + keyA;
                    const unsigned long long va = *(const LAS unsigned long long*)vp;
                    const unsigned long long vb = (pr < 4) ? *(const LAS unsigned long long*)(vp + 16) : 0ull;
                    v4u w; w.x = (unsigned)va; w.y = (unsigned)(va >> 32); w.z = (unsigned)vb; w.w = (unsigned)(vb >> 32);
                    o[dt] = __builtin_amdgcn_mfma_f32_16x16x32_bf16(__builtin_bit_cast(bf16x8v, w), Pf, o[dt], 0, 0, 0);
                }
            }
            const float inv = 1.0f / sum;
#pragma unroll
            for (int dt = 0; dt < 4; ++dt)
                *(GAS unsigned long long*)(ATT + qrow * 512 + h * 64 + 16 * dt + 4 * lq) = (unsigned long long)cvtpk(o[dt][0] * inv, o[dt][1] * inv) | ((unsigned long long)cvtpk(o[dt][2] * inv, o[dt][3] * inv) << 32);
        }
    }
}
struct Args { const float* in[22]; float* out; unsigned char* ws; };
__global__ void __launch_bounds__(NWAVES * 64, 2) mk_fwd(Args args) {
    extern __shared__ __attribute__((aligned(16))) unsigned char lds[];
    LAS unsigned char* const L3 = (LAS unsigned char*)lds;
    volatile LAS unsigned* const MISC = (volatile LAS unsigned*)(L3 + MISC_OFF);
    const int tid = threadIdx.x, lane = tid & 63, wave = __builtin_amdgcn_readfirstlane(tid >> 6);
    const int G = gridDim.x; const int bx = blockIdx.x; const int vcu = (G % 8 == 0) ? (bx % 8) * (G / 8) + bx / 8 : bx;
    const int gw = vcu * NWAVES + wave, NGW = G * NWAVES;
    unsigned char* const ws = args.ws;
    const float* x = args.in[0];
    const float *g_pre = args.in[1], *g_post = args.in[2], *g_mpre = args.in[3], *g_mpost = args.in[4];
    const float *w_in = args.in[5], *rel_bias = args.in[6], *sinks = args.in[7];
    const float *lam_re = args.in[8], *lam_im = args.in[9], *log_dt = args.in[10], *b_re = args.in[11], *b_im = args.in[12], *c_re = args.in[13], *c_im = args.in[14], *d_skip = args.in[15];
    const float *w_glu = args.in[16], *w_ab = args.in[17], *w_sb = args.in[18], *w_out = args.in[19], *w_ff1 = args.in[20], *w_ff2 = args.in[21];
    float* const out = args.out;
    bf16 *Win_t = (bf16*)(ws + WS_WIN), *Wglu_t = (bf16*)(ws + WS_WGLU), *Wab_t = (bf16*)(ws + WS_WAB), *Wsb_t = (bf16*)(ws + WS_WSB), *Wout_t = (bf16*)(ws + WS_WOUT), *Wff1_t = (bf16*)(ws + WS_WFF1), *Wff2_t = (bf16*)(ws + WS_WFF2);
    bf16 *XN = (bf16*)(ws + WS_XN), *Qb = (bf16*)(ws + WS_Q), *KVb = (bf16*)(ws + WS_KV), *Ub = (bf16*)(ws + WS_U), *GA = (bf16*)(ws + WS_GA), *GS = (bf16*)(ws + WS_GS);
    bf16 *ATT = (bf16*)(ws + WS_ATT), *Zb = (bf16*)(ws + WS_Z), *Z2 = (bf16*)(ws + WS_Z2), *YA = (bf16*)(ws + WS_YA), *MG = (bf16*)(ws + WS_MG), *F1 = (bf16*)(ws + WS_F1);
    float *Sst = (float*)(ws + WS_S), *Ob = (float*)(ws + WS_O), *F2 = (float*)(ws + WS_F2);
    bf16* Ktab = (bf16*)(ws + WS_KTAB); float *PWr = (float*)(ws + WS_PWR), *PWi = (float*)(ws + WS_PWI), *BBr = (float*)(ws + WS_BBR), *BBi = (float*)(ws + WS_BBI), *BBtr = (float*)(ws + WS_BBTR), *BBti = (float*)(ws + WS_BBTI), *Tst = (float*)(ws + WS_T);
    bf16* E16 = (bf16*)(ws + WS_E16);

    for (int u = tid; u < (LDS_BYTES - LDSCTL_OFF) / 4; u += NWAVES * 64) ((LAS unsigned*)(L3 + LDSCTL_OFF))[u] = 0u;
    __syncthreads();
    const XcdBarrier bar = xcd_barrier_post((unsigned*)(ws + WS_CTL) + CW_BAR, MISC + 8);

    for (int rep = 0; rep < (PROBE_DUP == 0 ? 2 : 1); ++rep) {
        LAS float* scr = (LAS float*)(L3 + wave * 16384);
        constexpr int I_IN = (D / 64) * (INW / 32), I_GLU = (512 / 64) * (512 / 32), I_AB = (512 / 64) * (D / 32), I_SB = I_AB, I_OUT = (D / 64) * (D / 32), I_F1 = (D / 64) * (DFF / 32), I_F2 = (DFF / 64) * (D / 32);
        constexpr int NITEMS = I_IN + I_GLU + I_AB + I_SB + I_OUT + I_F1 + I_F2;
        for (int rep2 = 0; rep2 < (PROBE_DUP == 100 ? 2 : 1); ++rep2)
        for (int it = gw; it < NITEMS; it += NGW) {
            int r = it;
            if (r < I_IN) { p0_transpose_item<true>(w_in, g_pre, D, INW, Win_t, scr, r, lane); continue; } r -= I_IN;
            if (r < I_GLU) { p0_transpose_item<false>(w_glu, nullptr, 512, 512, Wglu_t, scr, r, lane); continue; } r -= I_GLU;
            if (r < I_AB) { p0_transpose_item<false>(w_ab, nullptr, 512, D, Wab_t, scr, r, lane); continue; } r -= I_AB;
            if (r < I_SB) { p0_transpose_item<false>(w_sb, nullptr, 512, D, Wsb_t, scr, r, lane); continue; } r -= I_SB;
            if (r < I_OUT) { p0_transpose_item<false>(w_out, nullptr, D, D, Wout_t, scr, r, lane); continue; } r -= I_OUT;
            if (r < I_F1) { p0_transpose_item<true>(w_ff1, g_mpre, D, DFF, Wff1_t, scr, r, lane); continue; } r -= I_F1;
            p0_transpose_item<false>(w_ff2, nullptr, DFF, D, Wff2_t, scr, r, lane);
        }
        for (int rep2 = 0; rep2 < (PROBE_DUP == 101 ? 2 : 1); ++rep2)
        for (int m = gw; m < M; m += NGW) rms_row_to_bf16(x + (size_t)m * D, XN + (size_t)m * D, lane);
        for (int rep2 = 0; rep2 < (PROBE_DUP == 102 ? 2 : 1); ++rep2)
        for (int unit = gw; unit < 32 * PWS + 32; unit += NGW) {
            if (unit < 32 * PWS) ssm_pw_unit(unit / PWS, unit % PWS, lane, lam_re, lam_im, log_dt, PWr, PWi);
            else ssm_bb_unit(unit - 32 * PWS, lane, lam_re, lam_im, log_dt, b_re, b_im, BBr, BBi, BBtr, BBti);
        }
    }
    xcd_barrier(bar);

    for (int rep = 0; rep < (PROBE_DUP == 21 ? 2 : 1); ++rep) { ssm_ktab_phase(PWr, PWi, BBtr, BBti, c_re, c_im, Ktab, gw, NGW, lane); ssm_e16_phase(PWr, PWi, BBr, BBi, E16, gw, NGW, lane); }
    for (int rep = 0; rep < (PROBE_DUP == 1 ? 2 : 1); ++rep) {
        pg8::Gemm g{XN, Win_t, M, INW, D}; pg8::StaticOrder S; S.init(M, INW, G, bx);
        pg8::EpiProj E{Qb, KVb, Ub, GA, GS};
        pg8::gemm_phase<pg8::EpiProj, pg8::StaticOrder, true, true>(L3, g, S, E);
    }
    xcd_barrier(bar);

    for (int rep = 0; rep < (PROBE_DUP == 22 ? 2 : 1); ++rep) attn_mfma_phase(L3, Qb, KVb, ATT, rel_bias, sinks, G, vcu, tid, lane, wave);
    for (int rep = 0; rep < (PROBE_DUP == 23 ? 2 : 1); ++rep) ssm_s_phase(L3, Ub, Sst, Tst, E16, PWr, PWi, G, vcu, tid, lane, wave);
    xcd_barrier(bar);

    for (int rep = 0; rep < (PROBE_DUP == 3 ? 2 : 1); ++rep) ssm_y_phase(L3, Ub, Sst, Tst, Zb, Ktab, PWr, PWi, c_re, c_im, d_skip, G, vcu, tid, lane, wave);
    xcd_barrier(bar);

    for (int rep = 0; rep < (PROBE_DUP == 4 ? 2 : 1); ++rep) {
        pg8::Gemm g{Zb, Wglu_t, M, 512, 512}; pg8::StaticOrder S; S.init(M, 512, G, bx);
        pg8::EpiGlu E{Zb, Z2};
        pg8::gemm_phase<pg8::EpiGlu, pg8::StaticOrder, true, true>(L3, g, S, E);
    }
    for (int rep = 0; rep < (PROBE_DUP == 41 ? 2 : 1); ++rep) {
        pg8::Gemm g{ATT, Wab_t, M, D, 512}; pg8::StaticOrder S; S.init(M, D, G, bx);
        pg8::EpiGate E{GA, nullptr, YA};
        pg8::gemm_phase<pg8::EpiGate, pg8::StaticOrder, true, true>(L3, g, S, E);
    }
    xcd_barrier(bar);

    for (int rep = 0; rep < (PROBE_DUP == 5 ? 2 : 1); ++rep) {
        pg8::Gemm g{Z2, Wsb_t, M, D, 512}; pg8::StaticOrder S; S.init(M, D, G, bx);
        pg8::EpiGate E{GS, YA, MG};
        pg8::gemm_phase<pg8::EpiGate, pg8::StaticOrder, true, true>(L3, g, S, E);
    }
    xcd_barrier(bar);

    for (int rep = 0; rep < (PROBE_DUP == 6 ? 2 : 1); ++rep) {
        pg8::Gemm g{MG, Wout_t, M, D, D}; pg8::StaticOrder S; S.init(M, D, G, bx);
        pg8::EpiF32 E{Ob, D};
        pg8::gemm_phase<pg8::EpiF32, pg8::StaticOrder, true, true>(L3, g, S, E);
    }
    xcd_barrier(bar);
    for (int rep = 0; rep < (PROBE_DUP == 61 ? 2 : 1); ++rep) for (int m = gw; m < M; m += NGW) res_norm_row(Ob + (size_t)m * D, x + (size_t)m * D, g_post, out + (size_t)m * D, XN + (size_t)m * D, lane);
    xcd_barrier(bar);

    for (int rep = 0; rep < (PROBE_DUP == 7 ? 2 : 1); ++rep) {
        pg8::Gemm g{XN, Wff1_t, M, DFF, D}; pg8::StaticOrder S; S.init(M, DFF, G, bx);
        pg8::EpiRelu2 E{F1, DFF};
        pg8::gemm_phase<pg8::EpiRelu2, pg8::StaticOrder, true, true>(L3, g, S, E);
    }
    xcd_barrier(bar);

    for (int rep = 0; rep < (PROBE_DUP == 8 ? 2 : 1); ++rep) {
        pg8::Gemm g{F1, Wff2_t, M, D, DFF}; pg8::StaticOrder S; S.init(M, D, G, bx);
        pg8::EpiF32 E{F2, D};
        pg8::gemm_phase<pg8::EpiF32, pg8::StaticOrder, true, true>(L3, g, S, E);
    }
    xcd_barrier(bar);
    for (int m = gw; m < M; m += NGW) res_norm_row(F2 + (size_t)m * D, out + (size_t)m * D, g_mpost, out + (size_t)m * D, nullptr, lane);
}

extern "C" void kernel_launch(void* const* d_in, const int* in_sizes, int n_in, void* d_out, int out_size, void* d_ws, size_t ws_size, hipStream_t stream) {
    static int grid = 0;
    if (grid == 0) {
        if (n_in != 22 || in_sizes[0] != M * D || out_size != M * D || ws_size < WS_END) { fprintf(stderr, "kernel_launch: unexpected shapes (n_in %d, in0 %d, out %d, ws %zu)\n", n_in, n_in > 0 ? in_sizes[0] : -1, out_size, ws_size); grid = -1; return; }
        int dev = 0, cus = 0, per_cu = 0;
        if (hipGetDevice(&dev) != hipSuccess || hipDeviceGetAttribute(&cus, hipDeviceAttributeMultiprocessorCount, dev) != hipSuccess) { grid = -1; return; }
        if (hipFuncSetAttribute((const void*)mk_fwd, hipFuncAttributeMaxDynamicSharedMemorySize, LDS_BYTES) != hipSuccess) { fprintf(stderr, "kernel_launch: hipFuncSetAttribute failed\n"); grid = -1; return; }
        if (hipOccupancyMaxActiveBlocksPerMultiprocessor(&per_cu, (const void*)mk_fwd, NWAVES * 64, LDS_BYTES) != hipSuccess || per_cu < 1) fprintf(stderr, "kernel_launch: occupancy query reports %d workgroups per CU\n", per_cu);
        (void)hipGetLastError();
        grid = cus;
    }
    if (grid < 0) return;
    if (hipMemsetAsync((char*)d_ws + WS_CTL, 0, CTL_ZERO_BYTES, stream) != hipSuccess) { fprintf(stderr, "kernel_launch: memset failed\n"); return; }
    Args a{};
    for (int i = 0; i < 22; ++i) a.in[i] = (const float*)d_in[i];
    a.out = (float*)d_out; a.ws = (unsigned char*)d_ws;
    hipLaunchKernelGGL(mk_fwd, dim3(grid), dim3(NWAVES * 64), LDS_BYTES, stream, a);
    const hipError_t le = hipPeekAtLastError();
    if (le != hipSuccess) fprintf(stderr, "kernel_launch: launch failed: %s\n", hipGetErrorName(le));
}
```
